# Optimizing an MI355X kernel written in HIP

```python
import math
import jax, jax.numpy as jnp
from jax import lax
import numpy as np

D_MODEL = 1024
BATCH = 8
SEQ = 2048
DEPTH = 1
DEC_BATCH = 128
DEC_SEQ = 4
PAST_LEN = 8192
PAGE_SIZE = 128

N_HEADS = 8
KV_HEADS = 2
GROUP = N_HEADS // KV_HEADS
HEAD_DIM = 64
Q_W = N_HEADS * HEAD_DIM
KV_W = KV_HEADS * HEAD_DIM
WINDOW = 128
REL_BUCKETS = 32
REL_MAX_DIST = 128
D_RNN = D_MODEL
RNN_BLOCKS = 16
RNN_BS = D_RNN // RNN_BLOCKS
CONV_W = 4
RG_C = 8.0
D_FF = 4 * D_MODEL
PLE_DIM = 256
EPS = 1e-6
NEG_INF = -1e30
IN_SIZES = (Q_W, KV_W, KV_W, D_RNN, D_RNN, D_MODEL, D_MODEL)
IN_COLS = sum(IN_SIZES)
IN_SPLITS = [int(s) for s in np.cumsum(IN_SIZES)[:-1]]

kernel_name = "hybrid_swa_sink_rglru_decode_step"


def rmsnorm(x, g):
    xf = x.astype(jnp.float32)
    y = xf * lax.rsqrt(jnp.mean(xf * xf, axis=-1, keepdims=True) + EPS) * g.astype(jnp.float32)
    return y.astype(x.dtype)


def rel_bucket(dist):
    n = jnp.maximum(dist, 0)
    max_exact = REL_BUCKETS // 2
    nf = jnp.maximum(n, 1).astype(jnp.float32)
    large = max_exact + (jnp.log(nf / max_exact) / math.log(REL_MAX_DIST / max_exact)
                         * (REL_BUCKETS - max_exact)).astype(jnp.int32)
    large = jnp.minimum(large, REL_BUCKETS - 1)
    return jnp.where(n < max_exact, n, large)


def window_attend(q, k, v, key_valid, sinks, rel_bias):
    B, N, Tq, H, Dh = q.shape
    Tk = k.shape[2]
    qg = q.reshape(B, N, Tq, KV_HEADS, GROUP, Dh)
    logits = jnp.einsum('bnqkgd,bnskd->bnkgqs', qg, k).astype(jnp.float32) * (Dh ** -0.5)
    dist = jnp.arange(Tq)[:, None] + (Tk - Tq) - jnp.arange(Tk)[None, :]
    bias = rel_bias[rel_bucket(dist)].astype(jnp.float32)
    bias = jnp.transpose(bias, (2, 0, 1)).reshape(KV_HEADS, GROUP, Tq, Tk)
    mask = (dist >= 0) & (dist <= WINDOW)
    mask = mask & key_valid[:, None, None, None, :]
    logits = jnp.where(mask, logits + bias, NEG_INF)
    sink = sinks.astype(jnp.float32).reshape(KV_HEADS, GROUP, 1, 1)
    m = jnp.maximum(jnp.max(logits, axis=-1, keepdims=True), sink)
    e = jnp.exp(logits - m)
    probs = e / (jnp.sum(e, axis=-1, keepdims=True) + jnp.exp(sink - m))
    out = jnp.einsum('bnkgqs,bnskd->bnqkgd', probs.astype(v.dtype), v)
    return out.reshape(B, N, Tq, H * Dh)


def causal_conv(x, prev, w, b):
    T = x.shape[1]
    xp = jnp.concatenate([prev.astype(x.dtype), x], axis=1)
    y = b + sum(w[j] * xp[:, j:j + T] for j in range(CONV_W))
    return y, xp[:, -(CONV_W - 1):]


def rglru(x, h0, wa, ba, wx, bx, lam):
    B, T, _ = x.shape
    xb = x.reshape(B, T, RNN_BLOCKS, RNN_BS)
    r = jax.nn.sigmoid((jnp.einsum('btnd,nde->btne', xb, wa).reshape(B, T, D_RNN) + ba).astype(jnp.float32))
    i = jax.nn.sigmoid((jnp.einsum('btnd,nde->btne', xb, wx).reshape(B, T, D_RNN) + bx).astype(jnp.float32))
    log_a = -RG_C * jax.nn.softplus(-lam.astype(jnp.float32)) * r
    a = jnp.exp(log_a)
    bterm = jnp.sqrt(-jnp.expm1(2.0 * log_a)) * (i * x.astype(jnp.float32))
    bterm = bterm.at[:, 0].add(a[:, 0] * h0.astype(jnp.float32))

    def combine(c1, c2):
        a1, b1 = c1
        a2, b2 = c2
        return a1 * a2, a2 * b1 + b2

    _, h = lax.associative_scan(combine, (a, bterm), axis=1)
    return h, h[:, -1]


def layer(x, p, k_past, v_past, conv_prev, h0, rel_bias, lw):
    B, T, _ = x.shape
    xn = rmsnorm(x, lw['norm1_g'])
    proj = xn @ lw['w_in']
    q, k, v, xr, gr, ga_logit, gr_logit = jnp.split(proj, IN_SPLITS, axis=-1)
    q = rmsnorm(q.reshape(B, T, N_HEADS, HEAD_DIM), lw['q_norm_g'])
    k = rmsnorm(k.reshape(B, T, KV_HEADS, HEAD_DIM), lw['k_norm_g'])
    v = v.reshape(B, T, KV_HEADS, HEAD_DIM)
    if k_past is None:
        nb = T // WINDOW
        qb = q.reshape(B, nb, WINDOW, N_HEADS, HEAD_DIM)
        kb = k.reshape(B, nb, WINDOW, KV_HEADS, HEAD_DIM)
        vb = v.reshape(B, nb, WINDOW, KV_HEADS, HEAD_DIM)
        kk = jnp.concatenate([jnp.concatenate([jnp.zeros_like(kb[:, :1]), kb[:, :-1]], axis=1), kb], axis=2)
        vv = jnp.concatenate([jnp.concatenate([jnp.zeros_like(vb[:, :1]), vb[:, :-1]], axis=1), vb], axis=2)
        key_valid = (jnp.arange(nb)[:, None] > 0) | (jnp.arange(2 * WINDOW)[None, :] >= WINDOW)
        att = window_attend(qb, kk, vv, key_valid, lw['sinks'], rel_bias).reshape(B, T, Q_W)
        k_all, v_all = k, v
        conv_prev = jnp.zeros((B, CONV_W - 1, D_RNN), x.dtype)
        h0 = jnp.zeros((B, D_RNN), jnp.float32)
    else:
        k_all = jnp.concatenate([k_past.astype(k.dtype), k], axis=1)
        v_all = jnp.concatenate([v_past.astype(v.dtype), v], axis=1)
        key_valid = jnp.ones((1, k_all.shape[1]), bool)
        att = window_attend(q[:, None], k_all[:, None], v_all[:, None], key_valid,
                            lw['sinks'], rel_bias)[:, 0]
    new_k = k_all[:, -WINDOW:]
    new_v = v_all[:, -WINDOW:]
    xc, new_conv = causal_conv(xr, conv_prev, lw['conv_w'], lw['conv_b'])
    h, h_last = rglru(xc, h0, lw['rg_wa'], lw['rg_ba'], lw['rg_wx'], lw['rg_bx'], lw['rg_lambda'])
    rnn = (h.astype(x.dtype) * jax.nn.gelu(gr)) @ lw['w_o_rnn']
    mix = (jax.nn.sigmoid(ga_logit) * (att @ lw['w_o_attn']) + jax.nn.sigmoid(gr_logit) * rnn) @ lw['w_out']
    x = x + mix
    hmid = jax.nn.relu(rmsnorm(x, lw['norm2_g']) @ lw['w_up'])
    x = x + (hmid * hmid) @ lw['w_down']
    gate = jax.nn.sigmoid(rmsnorm(x, lw['ple_norm_g']) @ lw['w_ple_gate'])
    x = x + gate * (p.astype(x.dtype) @ lw['w_ple'])
    return x, new_k, new_v, new_conv, h_last


def setup_inputs(seed: int = 0) -> dict:
    key = jax.random.key(seed)
    ks = jax.random.split(key, 32)
    f32 = jnp.float32

    def nrm(k, shape, scale=1.0):
        return jax.random.normal(k, shape, f32) * scale

    def gain(k, n):
        return 1.0 + 0.02 * jax.random.normal(k, (DEPTH, n), f32)

    u = jax.random.uniform(ks[20], (DEPTH, D_RNN), f32, minval=0.9, maxval=0.999)
    a0 = u ** (1.0 / RG_C)
    return {
        'x_prompt': nrm(ks[0], (BATCH, SEQ, D_MODEL)),
        'x_sample': nrm(ks[1], (DEC_BATCH, DEC_SEQ, D_MODEL)),
        'cache_k_win': nrm(ks[2], (DEPTH, DEC_BATCH, WINDOW, KV_HEADS, HEAD_DIM)),
        'cache_v_win': nrm(ks[3], (DEPTH, DEC_BATCH, WINDOW, KV_HEADS, HEAD_DIM)),
        'state_conv': nrm(ks[4], (DEPTH, DEC_BATCH, CONV_W - 1, D_RNN)),
        'state_h': nrm(ks[5], (DEPTH, DEC_BATCH, D_RNN), 0.5),
        'p_prompt': nrm(ks[6], (DEPTH, BATCH, SEQ, PLE_DIM)),
        'p_sample': nrm(ks[7], (DEPTH, DEC_BATCH, DEC_SEQ, PLE_DIM)),
        'rel_bias': nrm(ks[8], (REL_BUCKETS, N_HEADS), 0.2),
        'norm1_g': gain(ks[9], D_MODEL),
        'w_in': nrm(ks[10], (DEPTH, D_MODEL, IN_COLS), D_MODEL ** -0.5),
        'q_norm_g': gain(ks[11], HEAD_DIM),
        'k_norm_g': gain(ks[12], HEAD_DIM),
        'sinks': nrm(ks[13], (DEPTH, N_HEADS), 0.5),
        'w_o_attn': nrm(ks[14], (DEPTH, Q_W, D_MODEL), Q_W ** -0.5),
        'conv_w': nrm(ks[15], (DEPTH, CONV_W, D_RNN), CONV_W ** -0.5),
        'conv_b': nrm(ks[16], (DEPTH, D_RNN), 0.02),
        'rg_wa': nrm(ks[17], (DEPTH, RNN_BLOCKS, RNN_BS, RNN_BS), RNN_BS ** -0.5),
        'rg_ba': nrm(ks[18], (DEPTH, D_RNN), 0.02),
        'rg_wx': nrm(ks[19], (DEPTH, RNN_BLOCKS, RNN_BS, RNN_BS), RNN_BS ** -0.5),
        'rg_bx': nrm(ks[21], (DEPTH, D_RNN), 0.02),
        'rg_lambda': jnp.log(a0) - jnp.log1p(-a0),
        'w_o_rnn': nrm(ks[22], (DEPTH, D_RNN, D_MODEL), D_RNN ** -0.5),
        'w_out': nrm(ks[23], (DEPTH, D_MODEL, D_MODEL), D_MODEL ** -0.5),
        'norm2_g': gain(ks[24], D_MODEL),
        'w_up': nrm(ks[25], (DEPTH, D_MODEL, D_FF), D_MODEL ** -0.5),
        'w_down': nrm(ks[26], (DEPTH, D_FF, D_MODEL), D_FF ** -0.5),
        'ple_norm_g': gain(ks[27], D_MODEL),
        'w_ple_gate': nrm(ks[28], (DEPTH, D_MODEL, D_MODEL), D_MODEL ** -0.5),
        'w_ple': nrm(ks[29], (DEPTH, PLE_DIM, D_MODEL), PLE_DIM ** -0.5),
    }


def reference(x_prompt, x_sample, cache_k_win, cache_v_win, state_conv, state_h, p_prompt, p_sample,
              rel_bias, norm1_g, w_in, q_norm_g, k_norm_g, sinks, w_o_attn, conv_w, conv_b,
              rg_wa, rg_ba, rg_wx, rg_bx, rg_lambda, w_o_rnn, w_out, norm2_g, w_up, w_down,
              ple_norm_g, w_ple_gate, w_ple):
    xp, xs = x_prompt, x_sample
    kp_l, vp_l, cp_l, hp_l, ksl, vsl, csl, hsl = [], [], [], [], [], [], [], []
    for i in range(DEPTH):
        lw = dict(norm1_g=norm1_g[i], w_in=w_in[i], q_norm_g=q_norm_g[i], k_norm_g=k_norm_g[i],
                  sinks=sinks[i], w_o_attn=w_o_attn[i], conv_w=conv_w[i], conv_b=conv_b[i],
                  rg_wa=rg_wa[i], rg_ba=rg_ba[i], rg_wx=rg_wx[i], rg_bx=rg_bx[i],
                  rg_lambda=rg_lambda[i], w_o_rnn=w_o_rnn[i], w_out=w_out[i], norm2_g=norm2_g[i],
                  w_up=w_up[i], w_down=w_down[i], ple_norm_g=ple_norm_g[i],
                  w_ple_gate=w_ple_gate[i], w_ple=w_ple[i])
        xp, kp, vp, cp, hp = layer(xp, p_prompt[i], None, None, None, None, rel_bias, lw)
        xs, kss, vss, css, hss = layer(xs, p_sample[i], cache_k_win[i], cache_v_win[i],
                                       state_conv[i], state_h[i], rel_bias, lw)
        kp_l.append(kp); vp_l.append(vp); cp_l.append(cp); hp_l.append(hp)
        ksl.append(kss); vsl.append(vss); csl.append(css); hsl.append(hss)
    return (xp, xs,
            jnp.stack(kp_l), jnp.stack(vp_l), jnp.stack(cp_l), jnp.stack(hp_l),
            jnp.stack(ksl), jnp.stack(vsl), jnp.stack(csl), jnp.stack(hsl))
```

```cpp
#include <hip/hip_runtime.h>
#include <cstdio>
#include <cstdint>

#ifndef MK_LAUNCHES
#define MK_LAUNCHES 1
#endif

#define LAS __attribute__((address_space(3)))
typedef unsigned short bf16;
typedef short bf16x8 __attribute__((ext_vector_type(8)));
typedef short s16x4 __attribute__((ext_vector_type(4)));
typedef float f32x4 __attribute__((ext_vector_type(4)));
typedef unsigned u32x4 __attribute__((ext_vector_type(4)));
typedef unsigned u32x2 __attribute__((ext_vector_type(2)));
typedef __bf16 bf16v2 __attribute__((ext_vector_type(2)));

constexpr int D = 1024, SEQ = 2048, NBAT = 8, MP = NBAT * SEQ, DB = 128, DS = 4, MS = DB * DS, M = MP + MS;
constexpr int QW = 512, KVW = 128, NIN = 4864, DFF = 4096, PLE = 256;
constexpr float EPS = 1e-6f;
constexpr size_t O_Y = 0, O_KP = (size_t)M * D, O_VP = O_KP + 8 * 128 * 128, O_CP = O_VP + 8 * 128 * 128, O_HP = O_CP + 8 * 3 * 1024,
                 O_KS = O_HP + 8 * 1024, O_VS = O_KS + (size_t)128 * 128 * 128, O_CS = O_VS + (size_t)128 * 128 * 128, O_HS = O_CS + 128 * 3 * 1024;
constexpr size_t MiB = 1u << 20;
constexpr size_t WS_CTL = 0, WS_FLAGS = 49152, WS_GBAR = 65536, CTL_ZERO_BYTES = 65536 + 8 * 13824;
constexpr size_t WS_WIN = 1 * MiB, WS_WOA = 11 * MiB, WS_WOR = 12 * MiB, WS_WOUT = 14 * MiB, WS_WUP = 16 * MiB, WS_WDN = 24 * MiB, WS_WPG = 32 * MiB,
                 WS_WPLE = 34 * MiB, WS_WRGA = 34 * MiB + 512 * 1024, WS_WRGX = 34 * MiB + 640 * 1024, WS_SS2 = 35 * MiB, WS_SS3 = 37 * MiB  , WS_AGG = 39 * MiB;
constexpr size_t WS_ACT = 40 * MiB, DOM_STRIDE = 108 * MiB;
constexpr size_t WS_QA = 40 * MiB, WS_K = 57 * MiB, WS_V = 62 * MiB;
constexpr size_t WS_X1B = 40 * MiB;
constexpr size_t WS_XR = 73 * MiB, WS_G2 = 73 * MiB, WS_PE = 73 * MiB;
constexpr size_t WS_PB = 106 * MiB;
constexpr size_t WS_XN = 124 * MiB, WS_MIX = 124 * MiB, WS_HMID = 124 * MiB;
constexpr size_t WS_GR = 157 * MiB, WS_SGA = 190 * MiB, WS_SGR = 223 * MiB, WS_END = 256 * MiB;
constexpr int LDS_BYTES = 147456, MISC_OFF = 131072 + 320;

__device__ __forceinline__ unsigned pk2(float lo, float hi) { bf16v2 v; v.x = (__bf16)lo; v.y = (__bf16)hi; return __builtin_bit_cast(unsigned, v); }
__device__ __forceinline__ float bflo(unsigned w) { return __builtin_bit_cast(float, w << 16); }
__device__ __forceinline__ float bfhi(unsigned w) { return __builtin_bit_cast(float, w & 0xffff0000u); }
__device__ __forceinline__ float fexp(float x) { return __builtin_amdgcn_exp2f(x * 1.44269504089f); }
__device__ __forceinline__ float fsigmoid(float x) { return __builtin_amdgcn_rcpf(1.0f + fexp(-x)); }
__device__ __forceinline__ f32x4 fsigmoid4(f32x4 x) { return (f32x4){fsigmoid(x[0]), fsigmoid(x[1]), fsigmoid(x[2]), fsigmoid(x[3])}; }
__device__ __forceinline__ float fgelu(float x) { const float u = x * x; return x * fsigmoid(x * (1.5957691216f + 0.0713548163f * u)); }
__device__ __forceinline__ float wave_sum(float v) {
#pragma unroll
    for (int o = 1; o < 64; o <<= 1) v += __shfl_xor(v, o);
    return v;
}
#define NT_LD(p) __builtin_nontemporal_load(p)
#define NT_ST(v, p) __builtin_nontemporal_store((v), (p))
__device__ __forceinline__ int lane_fresh() { int l; asm volatile("v_mbcnt_lo_u32_b32 %0, -1, 0\n\tv_mbcnt_hi_u32_b32 %0, -1, %0" : "=v"(l)); return l; }
#define LDS_WAIT() asm volatile("s_waitcnt lgkmcnt(0)" ::: "memory")
#define VM_WAIT() asm volatile("s_waitcnt vmcnt(0)" ::: "memory")
#define MFMA16(a, b, c) __builtin_amdgcn_mfma_f32_16x16x32_bf16((a), (b), (c), 0, 0, 0)

#define XB_TMO      128
#define XB_XCNT(j)  (256  + 64 * (j))
#define XB_XSUB(j)  (1280 + 64 * (j))
#define XB_XGEN(j)  (2304 + 64 * (j))
#define XB_TOP      3328
#define XB_TOPGEN   3392
#define XCD_BAR_WORDS 3456
#define XB_SPIN_CAP (1u << 18)
__device__ __forceinline__ unsigned xb_ld(unsigned* p)              { return __hip_atomic_load(p, __ATOMIC_RELAXED, __HIP_MEMORY_SCOPE_AGENT); }
__device__ __forceinline__ unsigned xb_add(unsigned* p, unsigned v) { return __hip_atomic_fetch_add(p, v, __ATOMIC_RELAXED, __HIP_MEMORY_SCOPE_AGENT); }
__device__ __forceinline__ unsigned xb_xcc_id() { return (unsigned)__builtin_amdgcn_s_getreg((3 << 11) | 20) & 0xFu; }
#define XB_SPIN(cond, bar) do { unsigned _sp = 0; while (cond) { __builtin_amdgcn_s_sleep(1); \
    if ((++_sp & 255u) == 0u) { if (xb_ld(&(bar)[XB_TMO])) break; if (_sp > XB_SPIN_CAP) { atomicAdd(&(bar)[XB_TMO], 1u); break; } } } } while (0)
__device__ __forceinline__ void xcd_barrier_post(unsigned* bar, int wid) { if (wid == 0 && lane_fresh() == 0) (void)xb_add(&bar[XB_XCNT(xb_xcc_id())], 1u); }
__device__ __forceinline__ void xcd_barrier_complete(unsigned* bar, unsigned x, unsigned& nloc, unsigned& nx, unsigned G) {
    unsigned sum, cnt, mine, sp = 0u;
    for (;;) {
        sum = 0u; cnt = 0u; mine = 0u;
#pragma unroll
        for (unsigned j = 0; j < 16; ++j) { const unsigned c = xb_ld(&bar[XB_XCNT(j)]); sum += c; cnt += (c > 0u) ? 1u : 0u; mine = (j == x) ? c : mine; }
        if (sum == G) break;
        __builtin_amdgcn_s_sleep(1);
        if ((++sp & 255u) == 0u) { if (xb_ld(&bar[XB_TMO])) break; if (sp > XB_SPIN_CAP) { atomicAdd(&bar[XB_TMO], 1u); break; } }
    }
    nloc = mine > 0u ? mine : 1u; nx = cnt > 0u ? cnt : 1u;
}
__device__ __forceinline__ void xcd_barrier(unsigned* bar, volatile LAS unsigned* st, unsigned ng, int wid, bool inner = false) {
    asm volatile("s_waitcnt vmcnt(0)" ::: "memory");
    __syncthreads();
    if (wid == 0 && lane_fresh() == 0) {
        const unsigned x = xb_xcc_id();
        __builtin_amdgcn_s_waitcnt(0);
        unsigned nloc = st[0], nx = st[1];
        if (nloc == 0u) { xcd_barrier_complete(bar, x, nloc, nx, ng); st[0] = nloc; st[1] = nx; }
        const unsigned k = st[2]; st[2] = k + 1u;
        const unsigned old = xb_add(&bar[XB_XSUB(x)], 1u);
        const unsigned gen = old / nloc;
        if (old + 1u == (gen + 1u) * nloc) {
            if (inner && nx == 1u) asm volatile("buffer_inv sc1\n\ts_waitcnt vmcnt(0)" ::: "memory");
            else asm volatile("buffer_wbl2 sc1\n\tbuffer_inv sc1\n\ts_waitcnt vmcnt(0)" ::: "memory");
            const unsigned og = xb_add(&bar[XB_TOP], 1u);
            const unsigned tg = og / nx;
            if (og + 1u == (tg + 1u) * nx) { xb_add(&bar[XB_TOPGEN], 1u); asm volatile("s_waitcnt vmcnt(0)" ::: "memory"); }
            else XB_SPIN(xb_ld(&bar[XB_TOPGEN]) == k, bar);
        } else {
            __builtin_amdgcn_fence(__ATOMIC_ACQUIRE, "agent");
            asm volatile("s_waitcnt vmcnt(0)" ::: "memory");
            XB_SPIN(xb_ld(&bar[XB_TOPGEN]) == k, bar);
        }
    }
    __syncthreads();
}

struct Args { const float* in[30]; float* out; unsigned char* ws; int ph_lo, ph_hi; };
template <int I> __device__ __forceinline__ const float* karg() {
    const float* p;
    asm volatile("s_load_dwordx2 %0, %1, %2\n\ts_waitcnt lgkmcnt(0)" : "=s"(p) : "s"(__builtin_amdgcn_kernarg_segment_ptr()), "n"(I * 8) : "memory");
    return p;
}
enum In { I_XP = 0, I_XS = 1, I_CK = 2, I_CV = 3, I_SCONV = 4, I_SH = 5, I_PP = 6, I_PS = 7, I_RELB = 8, I_N1G = 9, I_WIN = 10, I_QG = 11, I_KG = 12, I_SINKS = 13, I_WOA = 14, I_CONVW = 15, I_CONVB = 16,
          I_RGWA = 17, I_RGBA = 18, I_RGWX = 19, I_RGBX = 20, I_RGLAM = 21, I_WOR = 22, I_WOUT = 23, I_N2G = 24, I_WUP = 25, I_WDN = 26, I_PNG = 27, I_WPG = 28, I_WPLE = 29, I_OUT = 30, I_WS = 31 };
struct Ctx { float* out; unsigned char* ws; unsigned char* wd; const float* p0; const float* p1; int G, c, dom; };
#define WSP(T, off) ((T*)(C.ws + (off)))
constexpr size_t GRP_STRIDE = DOM_STRIDE / 4;
__device__ __forceinline__ int row_grp(int l) { return l < 8192 ? (l >> 11) : ((l - 8192) >> 6); }
__device__ __forceinline__ int row_loc(int l) { return l < 8192 ? (l & 2047) : 2048 + ((l - 8192) & 63); }
#define WSG(T, off, lrow) ((T*)(C.wd + (size_t)row_grp(lrow) * GRP_STRIDE + ((off) - WS_ACT) / 8))
#define LR(m) ((m) < MP ? (m) - 8192 * C.dom : (m) - (MP + 256 * C.dom - 8192))

constexpr int BM = 256, BK = 64, HALF = 128, HTB = HALF * BK * 2, NXCD = 8, WGM = 8;
__device__ __forceinline__ int lds_byte(int r, int c) { const int st = (r >> 4) * 2 + (c >> 5), rr = r & 15, cc = c & 31, ob = rr * 64 + cc * 2; return st * 1024 + (ob ^ (((ob >> 9) & 1) << 5)); }
__device__ __forceinline__ void stage_rc(int b, int& R, int& C) { const int st = b / 1024, sb = b % 1024, swz = sb ^ (((sb >> 9) & 1) << 5); R = (st >> 1) * 16 + swz / 64; C = (st & 1) * 32 + (swz % 64) / 2; }
__device__ __forceinline__ int perm32(int rho) { const int n = rho >> 4, i = rho & 15; return 8 * (i >> 2) + 4 * n + (i & 3); }

enum Kind { K_IN = 0, K_ATT = 1, K_RNN = 2, K_OUT = 3, K_PE = 4, K_UP = 5, K_DOWN = 6, K_PLE = 7, K_ATTS = 8, K_RNNS = 9 };
enum Phase { PH_IN = 1, PH_P2 = 2, PH_MIX = 3, PH_OUT = 4, PH_UP = 5, PH_DOWN = 6, PH_PLE = 7 };
struct Unit { const char* A; const char* B; int K; int kind; int row0; int lrow0; int col0; };

__device__ __forceinline__ void tile_order(int L, int nM, int nN, int& pm, int& pn) {
    constexpr int NX = 4;
    const int nwg = nM * nN; int wgid = L;
    { const int q = nwg / NX, r = nwg % NX, xcd = wgid % NX, off = wgid / NX; wgid = (xcd < r ? xcd * (q + 1) : r * (q + 1) + (xcd - r) * q) + off; }
    const int nig = WGM * nN, gid = wgid / nig, fm = gid * WGM, gsz = (nM - fm) < WGM ? (nM - fm) : WGM;
    pm = fm + ((wgid % nig) % gsz); pn = (wgid % nig) / gsz;
}
template <int PH> struct Sched {
    int G, c, dom; const char* ws; const char* wd;
    __device__ __forceinline__ bool next(int i, Unit& u) const {
        int pmd, pn;
        if constexpr (PH == PH_IN) {
            if (G == 128) {
                const int k = c & 3, j = c >> 2;
                const bool donor = (k == 1 && j >= 26 && j <= 28) || (k == 2 && j == 24), recv = (k == 1 && j >= 29) || (k == 2 && j == 29);
                if (i > 4) return false;
                int off = 32 * i + j;
                if (donor) { if (i == 4) return false; if (i == 3) off = 128 + j; }
                else if (recv) { if (i == 4) off = 96 + (k == 1 ? j - 3 : 24); }
                else if (off >= (k < 3 ? 157 : 156)) return false;
                if (off < 152) { pmd = 8 * k + (off & 7); pn = off >> 3; } else { pmd = 32; pn = 5 * k + (off - 152); }
            } else { const int L = i * G + c; if (L >= 33 * 19) return false; tile_order(L, 33, 19, pmd, pn); } }
        else if constexpr (PH == PH_MIX) { const int L = (i >> 1) * G + c; if (L >= 128) return false; tile_order(L, 32, 4, pmd, pn); }
        else if constexpr (PH == PH_OUT) { const int n1 = c < 128 ? (128 - c + G - 1) / G : 0; const int L = (i < n1 ? i : i - n1) * G + c; if (i >= n1 && L >= 128) return false; tile_order(L, 32, 4, pmd, pn); }
        else if constexpr (PH == PH_UP) { const int L = i * G + c; if (L >= 32 * 16) return false; tile_order(L, 32, 16, pmd, pn); }
        else { const int L = i * G + c; if (L >= 128) return false; tile_order(L, 32, 4, pmd, pn); }
        const int pm = pmd < 32 ? dom * 32 + pmd : 64 + dom;
        if constexpr (PH == PH_IN) { u.A = pmd < 32 ? wd + (size_t)(pmd >> 3) * GRP_STRIDE + (WS_XN - WS_ACT) / 8 + (size_t)(pmd & 7) * 256 * 1024 * 2 : wd + (WS_XN - WS_ACT) / 8 + (size_t)2048 * 1024 * 2;     u.B = ws + WS_WIN + (size_t)pn * 256 * 1024 * 2; u.K = 1024; u.kind = K_IN; }
        else if constexpr (PH == PH_MIX) {
            if ((i & 1) == 0) { u.A = wd + (size_t)(pmd >> 3) * GRP_STRIDE + (WS_QA - WS_ACT) / 8 + (size_t)(pmd & 7) * 256 * 512 * 2; u.B = ws + WS_WOA + (size_t)pn * 256 * 512 * 2; u.K = 512; u.kind = K_ATT; }
            else { u.A = wd + (size_t)(pmd >> 3) * GRP_STRIDE + (WS_GR - WS_ACT) / 8 + (size_t)(pmd & 7) * 256 * 1024 * 2; u.B = ws + WS_WOR + (size_t)pn * 256 * 1024 * 2; u.K = 1024; u.kind = K_RNN; } }
        else if constexpr (PH == PH_OUT) { const int n1 = c < 128 ? (128 - c + G - 1) / G : 0;
            if (i < n1) { u.A = wd + (size_t)(pmd >> 3) * GRP_STRIDE + (WS_MIX - WS_ACT) / 8 + (size_t)(pmd & 7) * 256 * 1024 * 2; u.B = ws + WS_WOUT + (size_t)pn * 256 * 1024 * 2; u.K = 1024; u.kind = K_OUT; }
            else { u.A = wd + (size_t)(pmd >> 3) * GRP_STRIDE + (WS_PB - WS_ACT) / 8 + (size_t)(pmd & 7) * 256 * 256 * 2; u.B = ws + WS_WPLE + (size_t)pn * 256 * 256 * 2; u.K = 256; u.kind = K_PE; } }
        else if constexpr (PH == PH_UP) { u.A = wd + (size_t)(pmd >> 3) * GRP_STRIDE + (WS_X1B - WS_ACT) / 8 + (size_t)(pmd & 7) * 256 * 1024 * 2; u.B = ws + WS_WUP + (size_t)pn * 256 * 1024 * 2; u.K = 1024; u.kind = K_UP; }
        else if constexpr (PH == PH_DOWN) { u.A = wd + (size_t)(pmd >> 3) * GRP_STRIDE + (WS_HMID - WS_ACT) / 8 + (size_t)(pmd & 7) * 256 * 4096 * 2; u.B = ws + WS_WDN + (size_t)pn * 256 * 4096 * 2; u.K = 4096; u.kind = K_DOWN; }
        else { u.A = wd + (size_t)(pmd >> 3) * GRP_STRIDE + (WS_X1B - WS_ACT) / 8 + (size_t)(pmd & 7) * 256 * 1024 * 2; u.B = ws + WS_WPG + (size_t)pn * 256 * 1024 * 2; u.K = 1024; u.kind = K_PLE; }
        u.row0 = pm * 256; u.lrow0 = pmd * 256; u.col0 = pn * 256; return true;
    }
};

__device__ __forceinline__ void st_bf16x8(bf16* p, const f32x4& a, const f32x4& b) { u32x4 w; w.x = pk2(a[0], a[1]); w.y = pk2(a[2], a[3]); w.z = pk2(b[0], b[1]); w.w = pk2(b[2], b[3]); *(u32x4*)p = w; }
__device__ __forceinline__ void st_bf16x8_wt(const Ctx& C, bf16* p, const f32x4& a, const f32x4& b) { u32x4 w; w.x = pk2(a[0], a[1]); w.y = pk2(a[2], a[3]); w.z = pk2(b[0], b[1]); w.w = pk2(b[2], b[3]);
    __builtin_amdgcn_raw_buffer_store_b128(w, __builtin_amdgcn_make_buffer_rsrc(C.wd, (short)0, 0x7fffffff, 0x00020000), (unsigned)((unsigned char*)p - C.wd), 0, 16); }
__device__ __forceinline__ void ld_bf16x8(const bf16* p, f32x4& a, f32x4& b) { const u32x4 w = *(const u32x4*)p; a = (f32x4){bflo(w.x), bfhi(w.x), bflo(w.y), bfhi(w.y)}; b = (f32x4){bflo(w.z), bfhi(w.z), bflo(w.w), bfhi(w.w)}; }
__device__ __forceinline__ float row_ss(const f32x4 (&v)[2][2]) {
    float s = 0.f;
#pragma unroll
    for (int bj = 0; bj < 2; ++bj)
#pragma unroll
        for (int n = 0; n < 2; ++n) s += (v[bj][n][0] * v[bj][n][0] + v[bj][n][1] * v[bj][n][1]) + (v[bj][n][2] * v[bj][n][2] + v[bj][n][3] * v[bj][n][3]);
    s += __shfl_xor(s, 16); s += __shfl_xor(s, 32); return s;
}
__device__ __forceinline__ float rstd_of(float ss) { return __builtin_amdgcn_rsqf(ss * (1.0f / 1024.0f) + EPS); }
template <int KIND>
__device__ __forceinline__ void epi_row(const Ctx& C, int rowu, int fr, int c64, int fq, f32x4 (&v)[2][2]) {
    const int lru = LR(rowu);
    const unsigned l512 = (unsigned)(fr * QW + 8 * fq), l128 = (unsigned)(fr * KVW + 8 * fq), l1k = (unsigned)(fr * D + 8 * fq), l4k = (unsigned)(fr * DFF + 8 * fq);
#define ST_IN(p_, a_, b_) do { if (rowu >= MP) st_bf16x8_wt(C, p_, a_, b_); else st_bf16x8(p_, a_, b_); } while (0)
    if constexpr (KIND == K_IN) {
        if (c64 < 768) {
            if (c64 < 640) {
                const float sc = __builtin_amdgcn_rsqf(row_ss(v) * (1.0f / 64.0f) + EPS) * (c64 < 512 ? 0.125f : 1.0f);
                const float* g = (c64 < 512 ? C.p0 : C.p1) + (unsigned)(8 * fq);
#pragma unroll
                for (int bj = 0; bj < 2; ++bj) { const f32x4 g0 = *(const f32x4*)(g + 32 * bj), g1 = *(const f32x4*)(g + 32 * bj + 4); v[bj][0] = v[bj][0] * g0 * sc; v[bj][1] = v[bj][1] * g1 * sc; }
            }
            if (c64 < 512) {
                bf16* ub = WSG(bf16, WS_QA, lru) + (size_t)row_loc(lru) * QW + c64;
#pragma unroll
                for (int bj = 0; bj < 2; ++bj) ST_IN(ub + l512 + 32 * bj, v[bj][0], v[bj][1]);
            } else {
                const bool isk = c64 < 640; const int ccu = c64 - (isk ? 512 : 640);
                bf16* ub = WSG(bf16, isk ? WS_K : WS_V, lru) + (size_t)row_loc(lru) * KVW + ccu;
#pragma unroll
                for (int bj = 0; bj < 2; ++bj) ST_IN(ub + l128 + 32 * bj, v[bj][0], v[bj][1]);
                if (rowu < MP) { const int b = rowu >> 11, tu = rowu & 2047;
                    if (tu >= SEQ - 128) { float* w = C.out + (isk ? O_KP : O_VP) + ((size_t)(b * 128 + tu - (SEQ - 128)) * 128 + ccu) + l128;
#pragma unroll
                        for (int bj = 0; bj < 2; ++bj) { *(f32x4*)(w + 32 * bj) = v[bj][0]; *(f32x4*)(w + 32 * bj + 4) = v[bj][1]; } } }
                else { const int bu = (rowu - MP) >> 2;
                    float* w = C.out + (isk ? O_KS : O_VS) + ((size_t)(bu * 128 + 124) * 128 + ccu) + (unsigned)((fr >> 2) * 16384 + (fr & 3) * 128 + 8 * fq);
#pragma unroll
                    for (int bj = 0; bj < 2; ++bj) { *(f32x4*)(w + 32 * bj) = v[bj][0]; *(f32x4*)(w + 32 * bj + 4) = v[bj][1]; } }
            }
        } else if (c64 < 1792) {
            const int ccu = c64 - 768;
            bf16* ub = WSG(bf16, WS_XR, lru) + (size_t)row_loc(lru) * D + ccu;
#pragma unroll
            for (int bj = 0; bj < 2; ++bj) ST_IN(ub + l1k + 32 * bj, v[bj][0], v[bj][1]);
            if (rowu < MP) { const int b = rowu >> 11, tu = rowu & 2047;
                if (tu == SEQ - 16 && fr >= 13) { float* w = C.out + O_CP + ((size_t)(b * 3 - 13) * D + ccu) + l1k;
#pragma unroll
                    for (int bj = 0; bj < 2; ++bj) { *(f32x4*)(w + 32 * bj) = v[bj][0]; *(f32x4*)(w + 32 * bj + 4) = v[bj][1]; } } }
            else { const int bu = (rowu - MP) >> 2;
                if ((fr & 3) >= 1) { float* w = C.out + O_CS + ((size_t)(bu * 3 - 1) * D + ccu) + (unsigned)((fr >> 2) * 3 * D + (fr & 3) * D + 8 * fq);
#pragma unroll
                    for (int bj = 0; bj < 2; ++bj) { *(f32x4*)(w + 32 * bj) = v[bj][0]; *(f32x4*)(w + 32 * bj + 4) = v[bj][1]; } } }
        } else {
            const bool isg = c64 < 2816; size_t off; int ccu;
            if (isg) { off = WS_GR; ccu = c64 - 1792; } else if (c64 < 3840) { off = WS_SGA; ccu = c64 - 2816; } else { off = WS_SGR; ccu = c64 - 3840; }
            bf16* ub = WSG(bf16, off, lru) + (size_t)row_loc(lru) * D + ccu;
#pragma unroll
            for (int bj = 0; bj < 2; ++bj) {
#pragma unroll
                for (int n = 0; n < 2; ++n)
#pragma unroll
                    for (int j = 0; j < 4; ++j) v[bj][n][j] = isg ? fgelu(v[bj][n][j]) : v[bj][n][j];
                ST_IN(ub + l1k + 32 * bj, v[bj][0], v[bj][1]); }
        }
#undef ST_IN
    } else if constexpr (KIND == K_ATT) {
        const bf16* ua = WSG(const bf16, WS_SGA, lru) + (size_t)row_loc(lru) * D + c64; bf16* ug = WSG(bf16, WS_G2, lru) + (size_t)row_loc(lru) * D + c64;
#pragma unroll
        for (int bj = 0; bj < 2; ++bj) { f32x4 a0, a1; ld_bf16x8(ua + l1k + 32 * bj, a0, a1); st_bf16x8(ug + l1k + 32 * bj, v[bj][0] * fsigmoid4(a0), v[bj][1] * fsigmoid4(a1)); }
    } else if constexpr (KIND == K_RNN) {
        const bf16* ur = WSG(const bf16, WS_SGR, lru) + (size_t)row_loc(lru) * D + c64; const bf16* ug = WSG(const bf16, WS_G2, lru) + (size_t)row_loc(lru) * D + c64; bf16* um = WSG(bf16, WS_MIX, lru) + (size_t)row_loc(lru) * D + c64;
#pragma unroll
        for (int bj = 0; bj < 2; ++bj) { f32x4 r0, r1, g0, g1; ld_bf16x8(ur + l1k + 32 * bj, r0, r1); ld_bf16x8(ug + l1k + 32 * bj, g0, g1); st_bf16x8(um + l1k + 32 * bj, g0 + v[bj][0] * fsigmoid4(r0), g1 + v[bj][1] * fsigmoid4(r1)); }
    } else if constexpr (KIND == K_ATTS) {
        const bf16* ua = WSG(const bf16, WS_SGA, lru) + (size_t)row_loc(lru) * D + c64; const bf16* ur = WSG(const bf16, WS_SGR, lru) + (size_t)row_loc(lru) * D + c64;
#pragma unroll
        for (int bj = 0; bj < 2; ++bj) { f32x4 a0, a1, r0, r1; ld_bf16x8(ua + l1k + 32 * bj, a0, a1); ld_bf16x8(ur + l1k + 32 * bj, r0, r1);
#pragma unroll
            for (int j = 0; j < 4; ++j) { v[bj][0][j] *= (1.f + fexp(-r0[j])) * __builtin_amdgcn_rcpf(1.f + fexp(-a0[j])); v[bj][1][j] *= (1.f + fexp(-r1[j])) * __builtin_amdgcn_rcpf(1.f + fexp(-a1[j])); } }
    } else if constexpr (KIND == K_RNNS) {
        const bf16* ur = WSG(const bf16, WS_SGR, lru) + (size_t)row_loc(lru) * D + c64; bf16* um = WSG(bf16, WS_MIX, lru) + (size_t)row_loc(lru) * D + c64;
#pragma unroll
        for (int bj = 0; bj < 2; ++bj) { f32x4 r0, r1; ld_bf16x8(ur + l1k + 32 * bj, r0, r1); st_bf16x8(um + l1k + 32 * bj, v[bj][0] * fsigmoid4(r0), v[bj][1] * fsigmoid4(r1)); }
    } else if constexpr (KIND == K_OUT || KIND == K_DOWN) {
        bf16* ub = WSG(bf16, WS_X1B, lru) + (size_t)row_loc(lru) * D + c64;
        if constexpr (KIND == K_OUT) {
            const float* src = (rowu < MP ? C.p0 + (size_t)rowu * D : C.p1 + (size_t)(rowu - MP) * D) + c64 + l1k;
#pragma unroll
            for (int bj = 0; bj < 2; ++bj) { v[bj][0] += *(const f32x4*)(src + 32 * bj); v[bj][1] += *(const f32x4*)(src + 32 * bj + 4); }
        } else {
#pragma unroll
            for (int bj = 0; bj < 2; ++bj) { f32x4 x0, x1; ld_bf16x8(ub + l1k + 32 * bj, x0, x1); v[bj][0] += x0; v[bj][1] += x1; }
        }
#pragma unroll
        for (int bj = 0; bj < 2; ++bj) st_bf16x8(ub + l1k + 32 * bj, v[bj][0], v[bj][1]);
        const float ss = row_ss(v);
        if (fq == 0) unsafeAtomicAdd(WSP(float, (KIND == K_OUT) ? WS_SS2 : WS_SS3) + rowu + fr, ss);
    } else if constexpr (KIND == K_PE) {
        bf16* ub = WSG(bf16, WS_PE, lru) + (size_t)row_loc(lru) * D + c64;
#pragma unroll
        for (int bj = 0; bj < 2; ++bj) st_bf16x8(ub + l1k + 32 * bj, v[bj][0], v[bj][1]);
    } else if constexpr (KIND == K_UP) {
        const float rs = rstd_of((WSP(const float, WS_SS2) + rowu)[fr]);
        bf16* ub = WSG(bf16, WS_HMID, lru) + (size_t)row_loc(lru) * DFF + c64;
#pragma unroll
        for (int bj = 0; bj < 2; ++bj) {
#pragma unroll
            for (int n = 0; n < 2; ++n)
#pragma unroll
                for (int j = 0; j < 4; ++j) { const float h = fmaxf(v[bj][n][j] * rs, 0.f); v[bj][n][j] = h * h; }
            st_bf16x8(ub + l4k + 32 * bj, v[bj][0], v[bj][1]); }
    } else {
        const float rs = rstd_of((WSP(const float, WS_SS3) + rowu)[fr]);
        float* dst = C.out + (size_t)rowu * D + c64 + l1k;
        const bf16* up = WSG(const bf16, WS_PE, lru) + (size_t)row_loc(lru) * D + c64; const bf16* ux = WSG(const bf16, WS_X1B, lru) + (size_t)row_loc(lru) * D + c64;
#pragma unroll
        for (int bj = 0; bj < 2; ++bj) { f32x4 p0, p1, y0, y1; ld_bf16x8(up + l1k + 32 * bj, p0, p1); ld_bf16x8(ux + l1k + 32 * bj, y0, y1);
#pragma unroll
            for (int j = 0; j < 4; ++j) { y0[j] += fsigmoid(v[bj][0][j] * rs) * p0[j]; y1[j] += fsigmoid(v[bj][1][j] * rs) * p1[j]; }
            *(f32x4*)(dst + 32 * bj) = y0; *(f32x4*)(dst + 32 * bj + 4) = y1; }
    }
}
template <int KIND>
__device__ __forceinline__ void epi_unit(const Ctx& C, f32x4 (&acc)[2][2][4][2], const Unit& u, int wr, int wc, int fr, int fq) {
    constexpr bool SW = (KIND != K_IN);
    const int c64 = u.col0 + 64 * wc + (SW ? 32 * wr : 0), sgn = (SW && wr) ? -32 : 32;
    const unsigned l1k = (unsigned)(fr * D + 8 * fq), l4k = (unsigned)(fr * DFF + 8 * fq);
#define ROWU(r) (u.row0 + ((r) >> 2) * HALF + wr * 64 + ((r) & 3) * 16)
#define LROWU(r) (u.lrow0 + ((r) >> 2) * HALF + wr * 64 + ((r) & 3) * 16)
#define ACC(r, bj, n) acc[(r) >> 2][bj][(r) & 3][n]
#define ZERO(r) do { ACC(r, 0, 0) = (f32x4){0.f, 0.f, 0.f, 0.f}; ACC(r, 0, 1) = (f32x4){0.f, 0.f, 0.f, 0.f}; ACC(r, 1, 0) = (f32x4){0.f, 0.f, 0.f, 0.f}; ACC(r, 1, 1) = (f32x4){0.f, 0.f, 0.f, 0.f}; } while (0)
    if constexpr (KIND == K_IN) {
#pragma unroll
        for (int r = 0; r < 8; ++r) { f32x4 v[2][2] = {{ACC(r, 0, 0), ACC(r, 0, 1)}, {ACC(r, 1, 0), ACC(r, 1, 1)}}; epi_row<KIND>(C, ROWU(r), fr, c64, fq, v); ZERO(r); }
    } else if constexpr (KIND == K_PE) {
#pragma unroll
        for (int r = 0; r < 8; ++r) {
#pragma unroll
            for (int bj = 0; bj < 2; ++bj) st_bf16x8(WSG(bf16, WS_PE, LROWU(r)) + (size_t)row_loc(LROWU(r)) * D + c64 + l1k + bj * sgn, ACC(r, bj, 0), ACC(r, bj, 1));
            ZERO(r); }
    } else if constexpr (KIND == K_ATT) {
        u32x4 a[8][2];
#pragma unroll
        for (int r = 0; r < 8; ++r)
#pragma unroll
            for (int bj = 0; bj < 2; ++bj) a[r][bj] = *(const u32x4*)(WSG(const bf16, WS_SGA, LROWU(r)) + (size_t)row_loc(LROWU(r)) * D + c64 + l1k + bj * sgn);
#pragma unroll
        for (int r = 0; r < 8; ++r) {
#pragma unroll
            for (int bj = 0; bj < 2; ++bj) { const u32x4 w = a[r][bj];
                st_bf16x8(WSG(bf16, WS_G2, LROWU(r)) + (size_t)row_loc(LROWU(r)) * D + c64 + l1k + bj * sgn, ACC(r, bj, 0) * fsigmoid4((f32x4){bflo(w.x), bfhi(w.x), bflo(w.y), bfhi(w.y)}), ACC(r, bj, 1) * fsigmoid4((f32x4){bflo(w.z), bfhi(w.z), bflo(w.w), bfhi(w.w)})); }
            ZERO(r); }
    } else if constexpr (KIND == K_RNN) {
#pragma unroll
        for (int b4 = 0; b4 < 8; b4 += 4) {
            u32x4 g[4][2], s[4][2];
#pragma unroll
            for (int q = 0; q < 4; ++q)
#pragma unroll
                for (int bj = 0; bj < 2; ++bj) { g[q][bj] = *(const u32x4*)(WSG(const bf16, WS_G2, LROWU(b4 + q)) + (size_t)row_loc(LROWU(b4 + q)) * D + c64 + l1k + bj * sgn); s[q][bj] = *(const u32x4*)(WSG(const bf16, WS_SGR, LROWU(b4 + q)) + (size_t)row_loc(LROWU(b4 + q)) * D + c64 + l1k + bj * sgn); }
#pragma unroll
            for (int q = 0; q < 4; ++q) { const int r = b4 + q;
#pragma unroll
                for (int bj = 0; bj < 2; ++bj) { const u32x4 gw = g[q][bj], sw = s[q][bj];
                    st_bf16x8(WSG(bf16, WS_MIX, LROWU(r)) + (size_t)row_loc(LROWU(r)) * D + c64 + l1k + bj * sgn,
                              (f32x4){bflo(gw.x), bfhi(gw.x), bflo(gw.y), bfhi(gw.y)} + ACC(r, bj, 0) * fsigmoid4((f32x4){bflo(sw.x), bfhi(sw.x), bflo(sw.y), bfhi(sw.y)}),
                              (f32x4){bflo(gw.z), bfhi(gw.z), bflo(gw.w), bfhi(gw.w)} + ACC(r, bj, 1) * fsigmoid4((f32x4){bflo(sw.z), bfhi(sw.z), bflo(sw.w), bfhi(sw.w)})); }
                ZERO(r); }
            asm volatile("" ::: "memory");
        }
    } else if constexpr (KIND == K_OUT) {
#pragma unroll
        for (int b4 = 0; b4 < 8; b4 += 4) {
            f32x4 x[4][2][2];
#pragma unroll
            for (int q = 0; q < 4; ++q) { const int rowu = ROWU(b4 + q); const float* src = (rowu < MP ? C.p0 + (size_t)rowu * D : C.p1 + (size_t)(rowu - MP) * D) + c64 + l1k;
#pragma unroll
                for (int bj = 0; bj < 2; ++bj) { x[q][bj][0] = NT_LD((const f32x4*)(src + bj * sgn)); x[q][bj][1] = NT_LD((const f32x4*)(src + bj * sgn + 4)); } }
#pragma unroll
            for (int q = 0; q < 4; ++q) { const int r = b4 + q; f32x4 v[2][2];
#pragma unroll
                for (int bj = 0; bj < 2; ++bj) { v[bj][0] = ACC(r, bj, 0) + x[q][bj][0]; v[bj][1] = ACC(r, bj, 1) + x[q][bj][1]; st_bf16x8(WSG(bf16, WS_X1B, LROWU(r)) + (size_t)row_loc(LROWU(r)) * D + c64 + l1k + bj * sgn, v[bj][0], v[bj][1]); }
                const float ss = row_ss(v);
                if (fq == 0) unsafeAtomicAdd(WSP(float, WS_SS2) + ROWU(r) + fr, ss);
                ZERO(r); }
            asm volatile("" ::: "memory");
        }
    } else if constexpr (KIND == K_UP) {
        float rs[8];
#pragma unroll
        for (int r = 0; r < 8; ++r) rs[r] = (WSP(const float, WS_SS2) + ROWU(r))[fr];
#pragma unroll
        for (int r = 0; r < 8; ++r) { const float k = rstd_of(rs[r]);
#pragma unroll
            for (int bj = 0; bj < 2; ++bj) { f32x4 h0 = ACC(r, bj, 0) * k, h1 = ACC(r, bj, 1) * k;
#pragma unroll
                for (int j = 0; j < 4; ++j) { const float a = fmaxf(h0[j], 0.f), b = fmaxf(h1[j], 0.f); h0[j] = a * a; h1[j] = b * b; }
                st_bf16x8(WSG(bf16, WS_HMID, LROWU(r)) + (size_t)row_loc(LROWU(r)) * DFF + c64 + l4k + bj * sgn, h0, h1); }
            ZERO(r); }
    } else if constexpr (KIND == K_DOWN) {
        u32x4 x[8][2];
#pragma unroll
        for (int r = 0; r < 8; ++r)
#pragma unroll
            for (int bj = 0; bj < 2; ++bj) x[r][bj] = *(const u32x4*)(WSG(const bf16, WS_X1B, LROWU(r)) + (size_t)row_loc(LROWU(r)) * D + c64 + l1k + bj * sgn);
#pragma unroll
        for (int r = 0; r < 8; ++r) { f32x4 v[2][2];
#pragma unroll
            for (int bj = 0; bj < 2; ++bj) { const u32x4 w = x[r][bj]; v[bj][0] = ACC(r, bj, 0) + (f32x4){bflo(w.x), bfhi(w.x), bflo(w.y), bfhi(w.y)}; v[bj][1] = ACC(r, bj, 1) + (f32x4){bflo(w.z), bfhi(w.z), bflo(w.w), bfhi(w.w)};
                st_bf16x8(WSG(bf16, WS_X1B, LROWU(r)) + (size_t)row_loc(LROWU(r)) * D + c64 + l1k + bj * sgn, v[bj][0], v[bj][1]); }
            const float ss = row_ss(v);
            if (fq == 0) unsafeAtomicAdd(WSP(float, WS_SS3) + ROWU(r) + fr, ss);
            ZERO(r); }
    } else {
#pragma unroll
        for (int b4 = 0; b4 < 8; b4 += 4) {
            u32x4 p[4][2], x[4][2]; float rs[4];
#pragma unroll
            for (int q = 0; q < 4; ++q) { rs[q] = (WSP(const float, WS_SS3) + ROWU(b4 + q))[fr];
#pragma unroll
                for (int bj = 0; bj < 2; ++bj) { p[q][bj] = NT_LD((const u32x4*)(WSG(const bf16, WS_PE, LROWU(b4 + q)) + (size_t)row_loc(LROWU(b4 + q)) * D + c64 + l1k + bj * sgn)); x[q][bj] = *(const u32x4*)(WSG(const bf16, WS_X1B, LROWU(b4 + q)) + (size_t)row_loc(LROWU(b4 + q)) * D + c64 + l1k + bj * sgn); } }
#pragma unroll
            for (int q = 0; q < 4; ++q) { const int r = b4 + q; const float k = rstd_of(rs[q]); float* dst = C.out + (size_t)ROWU(r) * D + c64 + l1k;
#pragma unroll
                for (int bj = 0; bj < 2; ++bj) { const u32x4 pw = p[q][bj], xw = x[q][bj];
                    f32x4 y0 = (f32x4){bflo(xw.x), bfhi(xw.x), bflo(xw.y), bfhi(xw.y)}, y1 = (f32x4){bflo(xw.z), bfhi(xw.z), bflo(xw.w), bfhi(xw.w)};
                    const f32x4 p0 = (f32x4){bflo(pw.x), bfhi(pw.x), bflo(pw.y), bfhi(pw.y)}, p1 = (f32x4){bflo(pw.z), bfhi(pw.z), bflo(pw.w), bfhi(pw.w)};
#pragma unroll
                    for (int j = 0; j < 4; ++j) { y0[j] += fsigmoid(ACC(r, bj, 0)[j] * k) * p0[j]; y1[j] += fsigmoid(ACC(r, bj, 1)[j] * k) * p1[j]; }
                    NT_ST(y0, (f32x4*)(dst + bj * sgn)); NT_ST(y1, (f32x4*)(dst + bj * sgn + 4)); }
                ZERO(r); }
            asm volatile("" ::: "memory");
        }
    }
#undef ROWU
#undef LROWU
#undef ACC
#undef ZERO
}

struct XLoad { u32x4 a, b; f32x4 x0, x1; float rs; };
template <int KIND>
__device__ __forceinline__ void epi_extra_load(const Ctx& C, XLoad& xl, const Unit& u, int wr, int wc, int fr, int fq) {
    const int pmd = u.lrow0 >> 8, lsu = 8192 + 8 * pmd, gsu = MP + 256 * C.dom + 8 * pmd, cx = u.col0 + 64 * wc + 32 * wr;
    const unsigned l1k = (unsigned)(fr * D + 8 * fq);
    xl.a = (u32x4){0u, 0u, 0u, 0u}; xl.b = (u32x4){0u, 0u, 0u, 0u}; xl.x0 = (f32x4){0.f, 0.f, 0.f, 0.f}; xl.x1 = (f32x4){0.f, 0.f, 0.f, 0.f}; xl.rs = 0.f;
    if (fr < 8) {
        if constexpr (KIND == K_ATT) { xl.a = *(const u32x4*)(WSG(const bf16, WS_SGA, lsu) + (size_t)row_loc(lsu) * D + cx + l1k); xl.b = *(const u32x4*)(WSG(const bf16, WS_SGR, lsu) + (size_t)row_loc(lsu) * D + cx + l1k); }
        else if constexpr (KIND == K_RNN) { xl.b = *(const u32x4*)(WSG(const bf16, WS_SGR, lsu) + (size_t)row_loc(lsu) * D + cx + l1k); }
        else if constexpr (KIND == K_OUT) { const float* s = C.p1 + (size_t)(gsu - MP) * D + cx + l1k; xl.x0 = NT_LD((const f32x4*)s); xl.x1 = NT_LD((const f32x4*)(s + 4)); }
        else if constexpr (KIND == K_UP) { xl.rs = (WSP(const float, WS_SS2) + gsu)[fr]; }
        else if constexpr (KIND == K_DOWN) { xl.a = *(const u32x4*)(WSG(const bf16, WS_X1B, lsu) + (size_t)row_loc(lsu) * D + cx + l1k); }
        else if constexpr (KIND == K_PLE) { xl.rs = (WSP(const float, WS_SS3) + gsu)[fr]; xl.a = *(const u32x4*)(WSG(const bf16, WS_X1B, lsu) + (size_t)row_loc(lsu) * D + cx + l1k); xl.b = NT_LD((const u32x4*)(WSG(const bf16, WS_PE, lsu) + (size_t)row_loc(lsu) * D + cx + l1k)); }
    }
}
#define UNPK_LO(q_) ((f32x4){bflo((q_).x), bfhi((q_).x), bflo((q_).y), bfhi((q_).y)})
#define UNPK_HI(q_) ((f32x4){bflo((q_).z), bfhi((q_).z), bflo((q_).w), bfhi((q_).w)})
template <int KIND>
__device__ __forceinline__ void epi_extra(const Ctx& C, f32x4 (&ax)[2], const XLoad& xl, const Unit& u, int wr, int wc, int fr, int fq) {
    const int pmd = u.lrow0 >> 8, lsu = 8192 + 8 * pmd, gsu = MP + 256 * C.dom + 8 * pmd, cx = u.col0 + 64 * wc + 32 * wr;
    const unsigned l1k = (unsigned)(fr * D + 8 * fq), l4k = (unsigned)(fr * DFF + 8 * fq);
    const bool ok = fr < 8;
    if constexpr (KIND == K_ATT) {
        const f32x4 a0 = UNPK_LO(xl.a), a1 = UNPK_HI(xl.a), r0 = UNPK_LO(xl.b), r1 = UNPK_HI(xl.b);
#pragma unroll
        for (int j = 0; j < 4; ++j) { ax[0][j] *= (1.f + fexp(-r0[j])) * __builtin_amdgcn_rcpf(1.f + fexp(-a0[j])); ax[1][j] *= (1.f + fexp(-r1[j])) * __builtin_amdgcn_rcpf(1.f + fexp(-a1[j])); }
        return;
    } else if constexpr (KIND == K_RNN) {
        if (ok) st_bf16x8(WSG(bf16, WS_MIX, lsu) + (size_t)row_loc(lsu) * D + cx + l1k, ax[0] * fsigmoid4(UNPK_LO(xl.b)), ax[1] * fsigmoid4(UNPK_HI(xl.b)));
    } else if constexpr (KIND == K_OUT || KIND == K_DOWN) {
        f32x4 v0, v1;
        if constexpr (KIND == K_OUT) { v0 = ax[0] + xl.x0; v1 = ax[1] + xl.x1; } else { v0 = ax[0] + UNPK_LO(xl.a); v1 = ax[1] + UNPK_HI(xl.a); }
        if (ok) st_bf16x8(WSG(bf16, WS_X1B, lsu) + (size_t)row_loc(lsu) * D + cx + l1k, v0, v1);
        float ss = (v0[0] * v0[0] + v0[1] * v0[1]) + (v0[2] * v0[2] + v0[3] * v0[3]) + (v1[0] * v1[0] + v1[1] * v1[1]) + (v1[2] * v1[2] + v1[3] * v1[3]);
        ss += __shfl_xor(ss, 16); ss += __shfl_xor(ss, 32);
        if (ok && fq == 0) unsafeAtomicAdd(WSP(float, (KIND == K_OUT) ? WS_SS2 : WS_SS3) + gsu + fr, ss);
    } else if constexpr (KIND == K_PE) {
        if (ok) st_bf16x8(WSG(bf16, WS_PE, lsu) + (size_t)row_loc(lsu) * D + cx + l1k, ax[0], ax[1]);
    } else if constexpr (KIND == K_UP) {
        const float k = rstd_of(xl.rs); f32x4 h0 = ax[0] * k, h1 = ax[1] * k;
#pragma unroll
        for (int j = 0; j < 4; ++j) { const float a = fmaxf(h0[j], 0.f), b = fmaxf(h1[j], 0.f); h0[j] = a * a; h1[j] = b * b; }
        if (ok) st_bf16x8(WSG(bf16, WS_HMID, lsu) + (size_t)row_loc(lsu) * DFF + cx + l4k, h0, h1);
    } else {
        const float k = rstd_of(xl.rs); f32x4 y0 = UNPK_LO(xl.a), y1 = UNPK_HI(xl.a); const f32x4 p0 = UNPK_LO(xl.b), p1 = UNPK_HI(xl.b);
#pragma unroll
        for (int j = 0; j < 4; ++j) { y0[j] += fsigmoid(ax[0][j] * k) * p0[j]; y1[j] += fsigmoid(ax[1][j] * k) * p1[j]; }
        if (ok) { float* dst = C.out + (size_t)gsu * D + cx + l1k; NT_ST(y0, (f32x4*)dst); NT_ST(y1, (f32x4*)(dst + 4)); }
    }
    ax[0] = (f32x4){0.f, 0.f, 0.f, 0.f}; ax[1] = (f32x4){0.f, 0.f, 0.f, 0.f};
}
#undef UNPK_LO
#undef UNPK_HI

template <int PH>
__device__ __forceinline__ int gemm_phase(LAS unsigned char* lds, const Ctx& C, int wid) {
    const int lane = lane_fresh(), tid = wid * 64 + lane, wr = wid >> 2, wc = wid & 3, fr = lane & 15, fq = lane >> 4;
    Sched<PH> S; S.G = C.G; S.c = C.c; S.dom = C.dom; S.ws = (const char*)C.ws; S.wd = (const char*)C.wd;
#define STAGE_IDS() int sRa[2], sRb[2], sC[2], xRC; { const int sl = lane_fresh(), stid = wid * 64 + sl; \
        _Pragma("unroll") for (int i = 0; i < 2; ++i) { int R, Cc; stage_rc(stid * 16 + i * 8192, R, Cc); sRa[i] = R; sRb[i] = 64 * (R >> 5) + perm32(R & 31); sC[i] = Cc; } \
        const int L = wid * 256 + sl * 4, st = L >> 10, sb = L & 1023, ob = sb ^ (((sb >> 9) & 1) << 5); xRC = (((ob >> 6) & 7) << 8) | (st * 32 + (ob & 63) / 2); }
    const size_t kstep = (size_t)(BK * 2);
    const unsigned ldsw = (unsigned)wid * 1024u;
    const int aoff = lds_byte(wr * 64 + fr, fq * 8), boff = lds_byte(wc * 32 + fr, fq * 8), xoffr = lds_byte(fr, fq * 8);
    constexpr bool XT = (PH != PH_IN);
    constexpr int XA_OFF = 131072 + 4096;
    const int boff0 = boff + (XT ? wr * HTB : 0), boff1 = boff + (XT ? (wr ^ 1) * HTB : HTB);
    const unsigned xldsw = (unsigned)wid * 256u;
#define PG8_XSTAGE(b, gbase, v) do { if constexpr (XT) __builtin_amdgcn_global_load_lds((const unsigned*)((const char*)(gbase) + (v)), (LAS unsigned*)(lds + XA_OFF + (b) * 2048 + xldsw), 4, 0, 0); } while (0)
#define PG8_LDX(b) do { if constexpr (XT) { Xt[0] = *(const LAS bf16x8*)(lds + XA_OFF + (b) * 2048 + xoffr); Xt[1] = *(const LAS bf16x8*)(lds + XA_OFF + (b) * 2048 + xoffr + 1024); } } while (0)
#define PG8_XMMA() do { if constexpr (XT) { __builtin_amdgcn_s_setprio(1); \
        _Pragma("unroll") for (int n = 0; n < 2; ++n) _Pragma("unroll") for (int k = 0; k < 2; ++k) accx[n] = __builtin_amdgcn_mfma_f32_16x16x32_bf16(B0[n][k], Xt[k], accx[n], 0, 0, 0); \
        __builtin_amdgcn_s_setprio(0); } } while (0)
#define XVOFF(u) ((unsigned)((xRC >> 8) * (u).K + (xRC & 255)) * 2u + (unsigned)((2048 - 248 * (((u).lrow0 >> 8) & 7)) * (u).K * 2))
#define PG8_SA(b, h) (((b) * 2 + (h)) * HTB)
#define PG8_SB(b, h) ((4 + (b) * 2 + (h)) * HTB)
#define PG8_STAGE(bufoff, gbase, v0, d1) do {   \
        __builtin_amdgcn_global_load_lds((const unsigned*)((const char*)(gbase) + (v0)), (LAS unsigned*)(lds + (bufoff) + ldsw), 16, 0, 0); \
        __builtin_amdgcn_global_load_lds((const unsigned*)((const char*)(gbase) + (d1) + (v0)), (LAS unsigned*)(lds + (bufoff) + ldsw + 8192), 16, 0, 0); } while (0)
#define PG8_LDA(dst, b, h) do { _Pragma("unroll") for (int m = 0; m < 4; ++m) _Pragma("unroll") for (int k = 0; k < 2; ++k) dst[m][k] = *(const LAS bf16x8*)(lds + PG8_SA(b, h) + aoff + m * 2048 + k * 1024); } while (0)
#define PG8_LDB(dst, b, h) do { _Pragma("unroll") for (int n = 0; n < 2; ++n) _Pragma("unroll") for (int k = 0; k < 2; ++k) dst[n][k] = *(const LAS bf16x8*)(lds + PG8_SB(b, 0) + ((h) ? boff1 : boff0) + n * 2048 + k * 1024); } while (0)
#define PG8_MMA(ai, bj, At, Bt) do { __builtin_amdgcn_s_setprio(1); _Pragma("unroll") for (int m = 0; m < 4; ++m) _Pragma("unroll") for (int n = 0; n < 2; ++n) _Pragma("unroll") for (int k = 0; k < 2; ++k) \
        acc[ai][bj][m][n] = __builtin_amdgcn_mfma_f32_16x16x32_bf16(Bt[n][k], At[m][k], acc[ai][bj][m][n], 0, 0, 0); __builtin_amdgcn_s_setprio(0); } while (0)
#define PG8_WAIT_V(n) asm volatile("s_waitcnt vmcnt(" #n ")" ::: "memory")
#define PG8_WAIT_LOOP() do { if constexpr (XT) PG8_WAIT_V(9); else PG8_WAIT_V(8); } while (0)
#define PG8_WAIT_L(n) asm volatile("s_waitcnt lgkmcnt(" #n ")" ::: "memory")
#define PG8_BAR __builtin_amdgcn_s_barrier()
#define PG8_SCHED __builtin_amdgcn_sched_barrier(0)
    Unit cur, nxt; int ui = 0, nsamp = 0;
    if (!S.next(0, cur)) return 0;
    f32x4 acc[2][2][4][2];
#pragma unroll
    for (int a = 0; a < 2; ++a)
#pragma unroll
        for (int b = 0; b < 2; ++b)
#pragma unroll
            for (int m = 0; m < 4; ++m)
#pragma unroll
                for (int n = 0; n < 2; ++n) acc[a][b][m][n] = (f32x4){0.f, 0.f, 0.f, 0.f};
    bf16x8 At[4][2], B0[2][2], B1[2][2], Xt[2];
    f32x4 accx[2] = {(f32x4){0.f, 0.f, 0.f, 0.f}, (f32x4){0.f, 0.f, 0.f, 0.f}};
    const char* cA = cur.A; const char* cB = cur.B; unsigned vX, vA0, vB0;
    { STAGE_IDS(); vX = XVOFF(cur); vA0 = (unsigned)(sRa[0] * cur.K + sC[0]) * 2u; vB0 = (unsigned)(sRb[0] * cur.K + sC[0]) * 2u; }
    unsigned hA = (PH == PH_IN && cur.lrow0 == 8192) ? (unsigned)(2 * GRP_STRIDE) : (unsigned)(HALF * cur.K * 2), hB = (unsigned)(32 * cur.K * 2);
    PG8_XSTAGE(0, cA, vX);
    PG8_STAGE(PG8_SB(0, 0), cB, vB0, hB * 4u); PG8_STAGE(PG8_SB(0, 1), cB + hB, vB0, hB * 4u); PG8_STAGE(PG8_SA(0, 0), cA, vA0, hA >> 1); PG8_STAGE(PG8_SA(0, 1), cA + hA, vA0, hA >> 1);
    if (wr == 1) PG8_BAR;
    PG8_WAIT_V(2); PG8_BAR;
    PG8_STAGE(PG8_SB(1, 0), cB + kstep, vB0, hB * 4u); PG8_STAGE(PG8_SA(1, 0), cA + kstep, vA0, hA >> 1); PG8_STAGE(PG8_SB(1, 1), cB + hB + kstep, vB0, hB * 4u);
    PG8_WAIT_V(6); PG8_BAR;
    for (;;) {
        const bool has_next = S.next(ui + 1, nxt);
        const char* nA = has_next ? nxt.A : cA; const char* nB = has_next ? nxt.B : cB; const int nK = has_next ? nxt.K : cur.K;
        unsigned nvX, nvA0, nvB0;
        { STAGE_IDS(); nvX = has_next ? XVOFF(nxt) : vX; nvA0 = (unsigned)(sRa[0] * nK + sC[0]) * 2u; nvB0 = (unsigned)(sRb[0] * nK + sC[0]) * 2u; }
        const unsigned nhA = (PH == PH_IN && has_next && nxt.lrow0 == 8192) ? (unsigned)(2 * GRP_STRIDE) : (unsigned)(HALF * nK * 2), nhB = (unsigned)(32 * nK * 2);
        const int nt = cur.K / BK;
        for (int t = 0; t < nt; t += 2) {
            const bool last = (t == nt - 2);
            const char* a1 = cA + (size_t)(t + 1) * kstep;
            const char* a2 = last ? nA : cA + (size_t)(t + 2) * kstep; const char* b2 = last ? nB : cB + (size_t)(t + 2) * kstep;
            const char* a3 = a2 + kstep; const char* b3 = b2 + kstep;
            const unsigned xA0 = last ? nvA0 : vA0, xB0 = last ? nvB0 : vB0;
            const unsigned xhA = last ? nhA : hA, xhB = last ? nhB : hB;
            const unsigned xvX = last ? nvX : vX;
            PG8_LDB(B0, 0, 0); PG8_LDB(B1, 0, 1); PG8_SCHED; PG8_LDA(At, 0, 0); PG8_STAGE(PG8_SA(1, 1), a1 + hA, vA0, hA >> 1); PG8_XSTAGE(1, a1, vX);
            PG8_WAIT_LOOP(); PG8_WAIT_L(0); PG8_BAR; PG8_MMA(0, 0, At, B0); PG8_MMA(0, 1, At, B1); PG8_BAR; PG8_SCHED;
            PG8_LDA(At, 0, 1); PG8_LDX(0); PG8_STAGE(PG8_SB(0, 0), b2, xB0, xhB * 4u); PG8_STAGE(PG8_SB(0, 1), b2 + xhB, xB0, xhB * 4u); PG8_STAGE(PG8_SA(0, 0), a2, xA0, xhA >> 1);
            PG8_WAIT_LOOP(); PG8_WAIT_L(0); PG8_BAR; PG8_MMA(1, 0, At, B0); PG8_MMA(1, 1, At, B1); PG8_XMMA(); PG8_BAR; PG8_SCHED;
            PG8_LDB(B0, 1, 0); PG8_LDB(B1, 1, 1); PG8_SCHED; PG8_LDA(At, 1, 0); PG8_STAGE(PG8_SA(0, 1), a2 + xhA, xA0, xhA >> 1); PG8_XSTAGE(0, a2, xvX);
            PG8_WAIT_LOOP(); PG8_WAIT_L(0); PG8_BAR; PG8_MMA(0, 0, At, B0); PG8_MMA(0, 1, At, B1); PG8_BAR; PG8_SCHED;
            PG8_LDA(At, 1, 1); PG8_LDX(1); PG8_STAGE(PG8_SB(1, 0), b3, xB0, xhB * 4u); PG8_STAGE(PG8_SB(1, 1), b3 + xhB, xB0, xhB * 4u); PG8_STAGE(PG8_SA(1, 0), a3, xA0, xhA >> 1);
            PG8_WAIT_LOOP(); PG8_WAIT_L(0); PG8_BAR; PG8_MMA(1, 0, At, B0); PG8_MMA(1, 1, At, B1); PG8_XMMA(); PG8_BAR; PG8_SCHED;
        }
        if (wr == 0) PG8_BAR;
        const int el = lane_fresh(), efr = el & 15, efq = el >> 4;
#define EPI(KIND) do { XLoad xl; epi_extra_load<KIND>(C, xl, cur, wr, wc, efr, efq); epi_unit<KIND>(C, acc, cur, wr, wc, efr, efq); epi_extra<KIND>(C, accx, xl, cur, wr, wc, efr, efq); } while (0)
        if constexpr (PH == PH_IN) epi_unit<K_IN>(C, acc, cur, wr, wc, efr, efq);
        else if constexpr (PH == PH_MIX) { if (cur.kind == K_ATT) EPI(K_ATT); else EPI(K_RNN); }
        else if constexpr (PH == PH_OUT) { if (cur.kind == K_OUT) EPI(K_OUT); else EPI(K_PE); }
        else if constexpr (PH == PH_UP) EPI(K_UP);
        else if constexpr (PH == PH_DOWN) EPI(K_DOWN);
        else EPI(K_PLE);
#undef EPI
        if constexpr (PH == PH_IN) nsamp += (cur.lrow0 == 8192) ? 1 : 0;
        if (!has_next) break;
        cur = nxt; cA = nA; cB = nB; vX = nvX; ++ui; vA0 = nvA0; vB0 = nvB0; hA = nhA; hB = nhB;
        if (wr == 1) PG8_BAR;
    }
    PG8_WAIT_V(0);
    PG8_BAR;
    return nsamp;
#undef STAGE_IDS
#undef PG8_XSTAGE
#undef PG8_LDX
#undef PG8_XMMA
#undef XVOFF
#undef PG8_WAIT_LOOP
#undef PG8_SA
#undef PG8_SB
#undef PG8_STAGE
#undef PG8_LDA
#undef PG8_LDB
#undef PG8_MMA
#undef PG8_WAIT_V
#undef PG8_WAIT_L
#undef PG8_BAR
#undef PG8_SCHED
}

__device__ __forceinline__ void p0_transpose_item(const float* W, int K, int N, bf16* WT, const float* gain, LAS float* scr, int item, int lane) {
    const int nblk = N / 32, kb = item / nblk, nb = item % nblk, k0 = 64 * kb, n0 = 32 * nb;
    const int kl = lane >> 3, n4 = (lane & 7) * 4;
    f32x4 w[8]; float g[8];
#pragma unroll
    for (int i = 0; i < 8; ++i) { w[i] = NT_LD((const f32x4*)(W + (size_t)(k0 + kl + 8 * i) * N + n0 + n4)); g[i] = gain ? gain[k0 + kl + 8 * i] : 1.f; }
#pragma unroll
    for (int i = 0; i < 8; ++i) { LAS float* s = scr + (kl + 8 * i) * 33 + n4; s[0] = w[i][0] * g[i]; s[1] = w[i][1] * g[i]; s[2] = w[i][2] * g[i]; s[3] = w[i][3] * g[i]; }
    LDS_WAIT(); asm volatile("" ::: "memory");
    const int c = lane & 7;
#pragma unroll
    for (int j = 0; j < 4; ++j) { const int n = (lane >> 3) + 8 * j; const LAS float* s = scr + (8 * c) * 33 + n;
        u32x4 o; o.x = pk2(s[0 * 33], s[1 * 33]); o.y = pk2(s[2 * 33], s[3 * 33]); o.z = pk2(s[4 * 33], s[5 * 33]); o.w = pk2(s[6 * 33], s[7 * 33]);
        *(u32x4*)(WT + (size_t)(n0 + n) * K + k0 + 8 * c) = o; }
    LDS_WAIT(); asm volatile("" ::: "memory");
}
__device__ __forceinline__ void p0a_prologue(const Ctx& C, LAS unsigned char* lds, int gi, int ng, int tid, int wave, int lane) {
    LAS float* scr = (LAS float*)(lds + wave * 16384);
    const int gw = gi * 8 + wave, NGW = ng * 8;
    {
        const float* xp = karg<I_XP>(); const float* xs = karg<I_XS>(); const float* pp = karg<I_PP>(); const float* ps = karg<I_PS>();
#pragma unroll 1
        for (int m0 = 2 * gw; m0 < M; m0 += 2 * NGW) {
            f32x4 v[2][4], pv[2];
#pragma unroll
            for (int r = 0; r < 2; ++r) { const int m = m0 + r;
                const f32x4* xr = (const f32x4*)(m < MP ? xp + (size_t)m * D : xs + (size_t)(m - MP) * D) + lane;
#pragma unroll
                for (int j = 0; j < 4; ++j) v[r][j] = xr[64 * j];
                pv[r] = NT_LD((const f32x4*)(m < MP ? pp + (size_t)m * PLE : ps + (size_t)(m - MP) * PLE) + lane); }
#pragma unroll
            for (int r = 0; r < 2; ++r) { const int m = m0 + r; float s = 0.f;
#pragma unroll
                for (int j = 0; j < 4; ++j) s += (v[r][j][0] * v[r][j][0] + v[r][j][1] * v[r][j][1]) + (v[r][j][2] * v[r][j][2] + v[r][j][3] * v[r][j][3]);
                const float rstd = __builtin_amdgcn_rsqf(wave_sum(s) * (1.f / D) + EPS);
                const int rd = m < MP ? (m >> 13) : ((m - MP) >> 8), rj = m < MP ? (m & 8191) : 8192 + ((m - MP) & 255);
            u32x2* o8 = (u32x2*)((bf16*)(C.ws + WS_ACT + (size_t)rd * DOM_STRIDE + (size_t)row_grp(rj) * GRP_STRIDE + (WS_XN - WS_ACT) / 8) + (size_t)row_loc(rj) * D) + lane;
#pragma unroll
                for (int j = 0; j < 4; ++j) { u32x2 w; w.x = pk2(v[r][j][0] * rstd, v[r][j][1] * rstd); w.y = pk2(v[r][j][2] * rstd, v[r][j][3] * rstd); o8[64 * j] = w; }
                u32x2 w; w.x = pk2(pv[r][0], pv[r][1]); w.y = pk2(pv[r][2], pv[r][3]);
                *((u32x2*)((bf16*)(C.ws + WS_ACT + (size_t)rd * DOM_STRIDE + (size_t)row_grp(rj) * GRP_STRIDE + (WS_PB - WS_ACT) / 8) + (size_t)row_loc(rj) * PLE) + lane) = w; }
        }
    }
    for (int i = gi * 512 + tid; i < 2048 * 64; i += ng * 512) WSP(unsigned long long, WS_AGG)[i] = 0ull;
    for (int i = gi * 512 + tid; i < M; i += ng * 512) { WSP(float, WS_SS2)[i] = 0.f; WSP(float, WS_SS3)[i] = 0.f; }
    constexpr int I_IN = 16 * (NIN / 32), I_RG = 2 * 16;
#pragma unroll 1
    for (int it = gw; it < I_IN + 2 * I_RG; it += NGW) {
        int r = it;
        if (r < I_IN) { p0_transpose_item(karg<I_WIN>(), D, NIN, WSP(bf16, WS_WIN), karg<I_N1G>(), scr, r, lane); continue; } r -= I_IN;
        if (r < I_RG) { p0_transpose_item(karg<I_RGWA>() + (size_t)(r >> 1) * 4096, 64, 64, WSP(bf16, WS_WRGA) + (size_t)(r >> 1) * 4096, nullptr, scr, r & 1, lane); continue; } r -= I_RG;
        p0_transpose_item(karg<I_RGWX>() + (size_t)(r >> 1) * 4096, 64, 64, WSP(bf16, WS_WRGX) + (size_t)(r >> 1) * 4096, nullptr, scr, r & 1, lane);
    }
}
__device__ __forceinline__ void cache_shift(const Ctx& C, int gi, int ng, int tid) {
    {
        const float* ck = karg<I_CK>(); const float* cv = karg<I_CV>();
        const int gt = gi * 512 + tid, NGT = ng * 512;
        constexpr int NQ = 2 * 128 * 3968;
#pragma unroll 1
        for (int idx0 = gt; idx0 < NQ; idx0 += 4 * NGT) {
            f32x4 t[4];
#pragma unroll
            for (int u = 0; u < 4; ++u) { const int idx = idx0 + u * NGT; if (idx < NQ) { const int arr = idx >= 128 * 3968, r = idx - arr * 128 * 3968, b = r / 3968, e4 = r % 3968;
                t[u] = NT_LD((const f32x4*)(arr ? cv : ck) + (size_t)b * 4096 + 128 + e4); } }
#pragma unroll
            for (int u = 0; u < 4; ++u) { const int idx = idx0 + u * NGT; if (idx < NQ) { const int arr = idx >= 128 * 3968, r = idx - arr * 128 * 3968, b = r / 3968, e4 = r % 3968;
                NT_ST(t[u], (f32x4*)(C.out + (arr ? O_VS : O_KS)) + (size_t)b * 4096 + e4); } }
        }
    }
}
struct P0Item { const float* W; bf16* WT; const float* gain; int K, N, r; };
__device__ __forceinline__ void p0_item_load(const P0Item& d, int lane, f32x4 (&w)[8], float (&g)[8]) {
    const int nblk = d.N / 32, kb = d.r / nblk, nb = d.r % nblk, k0 = 64 * kb, n0 = 32 * nb, kl = lane >> 3, n4 = (lane & 7) * 4;
#pragma unroll
    for (int i = 0; i < 8; ++i) { w[i] = NT_LD((const f32x4*)(d.W + (size_t)(k0 + kl + 8 * i) * d.N + n0 + n4)); g[i] = d.gain ? d.gain[k0 + kl + 8 * i] : 1.f; }
}
__device__ __forceinline__ void p0_item_finish(const P0Item& d, int lane, LAS float* scr, const f32x4 (&w)[8], const float (&g)[8]) {
    const int nblk = d.N / 32, kb = d.r / nblk, nb = d.r % nblk, k0 = 64 * kb, n0 = 32 * nb, kl = lane >> 3, n4 = (lane & 7) * 4;
#pragma unroll
    for (int i = 0; i < 8; ++i) { LAS float* s = scr + (kl + 8 * i) * 33 + n4; s[0] = w[i][0] * g[i]; s[1] = w[i][1] * g[i]; s[2] = w[i][2] * g[i]; s[3] = w[i][3] * g[i]; }
    LDS_WAIT(); asm volatile("" ::: "memory");
    const int c = lane & 7;
#pragma unroll
    for (int j = 0; j < 4; ++j) { const int n = (lane >> 3) + 8 * j; const LAS float* s = scr + (8 * c) * 33 + n;
        u32x4 o; o.x = pk2(s[0 * 33], s[1 * 33]); o.y = pk2(s[2 * 33], s[3 * 33]); o.z = pk2(s[4 * 33], s[5 * 33]); o.w = pk2(s[6 * 33], s[7 * 33]);
        __builtin_amdgcn_raw_buffer_store_b128(o, __builtin_amdgcn_make_buffer_rsrc(d.WT, (short)0, 0x7fffffff, 0x00020000), (unsigned)(((n0 + n) * d.K + k0 + 8 * c) * 2), 0, 16); }
    LDS_WAIT(); asm volatile("" ::: "memory");
}
__device__ __forceinline__ void p0b_prologue(const Ctx& C, LAS unsigned char* lds, int gi, int ng, int it_begin, int it_end, int tid, int wave, int lane) {
    LAS float* scr = (LAS float*)(lds + wave * 16384);
    const int gw = gi * 8 + wave, NGW = ng * 8;
    constexpr int I_OA = 8 * 32, I_SQ = 16 * 32, I_UP = 16 * 128, I_DN = 64 * 32, I_PLE = 4 * 32;
    constexpr int NITEMS = I_OA + 3 * I_SQ + I_UP + I_DN + I_PLE;
#define P0B_DESC(d, it_) do { int r = (it_); \
        if (r < I_OA) { d.W = karg<I_WOA>(); d.K = QW; d.N = D; d.WT = WSP(bf16, WS_WOA); d.gain = nullptr; } else { r -= I_OA; \
        if (r < I_SQ) { d.W = karg<I_WOR>(); d.K = D; d.N = D; d.WT = WSP(bf16, WS_WOR); d.gain = nullptr; } else { r -= I_SQ; \
        if (r < I_SQ) { d.W = karg<I_WOUT>(); d.K = D; d.N = D; d.WT = WSP(bf16, WS_WOUT); d.gain = nullptr; } else { r -= I_SQ; \
        if (r < I_SQ) { d.W = karg<I_WPG>(); d.K = D; d.N = D; d.WT = WSP(bf16, WS_WPG); d.gain = karg<I_PNG>(); } else { r -= I_SQ; \
        if (r < I_UP) { d.W = karg<I_WUP>(); d.K = D; d.N = DFF; d.WT = WSP(bf16, WS_WUP); d.gain = karg<I_N2G>(); } else { r -= I_UP; \
        if (r < I_DN) { d.W = karg<I_WDN>(); d.K = DFF; d.N = D; d.WT = WSP(bf16, WS_WDN); d.gain = nullptr; } else { r -= I_DN; \
        d.W = karg<I_WPLE>(); d.K = PLE; d.N = D; d.WT = WSP(bf16, WS_WPLE); d.gain = nullptr; } } } } } } d.r = r; } while (0)
    if (it_end > NITEMS) it_end = NITEMS;
#pragma unroll 1
    for (int it = it_begin + gw; it < it_end; it += 2 * NGW) {
        P0Item d0, d1; f32x4 w0[8], w1[8]; float g0[8], g1[8];
        const bool two = it + NGW < it_end;
        P0B_DESC(d0, it); p0_item_load(d0, lane, w0, g0);
        if (two) { P0B_DESC(d1, it + NGW); p0_item_load(d1, lane, w1, g1); }
        p0_item_finish(d0, lane, scr, w0, g0);
        if (two) p0_item_finish(d1, lane, scr, w1, g1);
    }
#undef P0B_DESC
}

__device__ __forceinline__ int rel_bucket(int n) {
    if (n < 16) return n;
    const float v = __logf((float)n * (1.0f / 16.0f)) / 2.0794415416798357f * 16.0f;
    const int l = 16 + (int)v; return l < 31 ? l : 31;
}
template <int NDT, int U, bool WAIT>
__device__ __forceinline__ void v_read(unsigned vb, s16x4 (&lo)[NDT], s16x4 (&hi)[NDT]) {
    constexpr int T0 = 2 * U, T1 = (2 * U + 1 < 9) ? 2 * U + 1 : 2 * U;
    if constexpr (NDT == 4) {
        if constexpr (WAIT)
        asm volatile("ds_read_b64_tr_b16 %0, %8 offset:%9\n\tds_read_b64_tr_b16 %1, %8 offset:%10\n\tds_read_b64_tr_b16 %2, %8 offset:%11\n\tds_read_b64_tr_b16 %3, %8 offset:%12\n\t"
                     "ds_read_b64_tr_b16 %4, %8 offset:%13\n\tds_read_b64_tr_b16 %5, %8 offset:%14\n\tds_read_b64_tr_b16 %6, %8 offset:%15\n\tds_read_b64_tr_b16 %7, %8 offset:%16\n\ts_waitcnt lgkmcnt(0)"
                     : "=&v"(lo[0]), "=&v"(lo[1]), "=&v"(lo[2]), "=&v"(lo[3]), "=&v"(hi[0]), "=&v"(hi[1]), "=&v"(hi[2]), "=&v"(hi[3])
                     : "v"(vb), "n"(T0 * 2304), "n"(T0 * 2304 + 32), "n"(T0 * 2304 + 64), "n"(T0 * 2304 + 96), "n"(T1 * 2304), "n"(T1 * 2304 + 32), "n"(T1 * 2304 + 64), "n"(T1 * 2304 + 96) : "memory");
        else
        asm volatile("ds_read_b64_tr_b16 %0, %8 offset:%9\n\tds_read_b64_tr_b16 %1, %8 offset:%10\n\tds_read_b64_tr_b16 %2, %8 offset:%11\n\tds_read_b64_tr_b16 %3, %8 offset:%12\n\t"
                     "ds_read_b64_tr_b16 %4, %8 offset:%13\n\tds_read_b64_tr_b16 %5, %8 offset:%14\n\tds_read_b64_tr_b16 %6, %8 offset:%15\n\tds_read_b64_tr_b16 %7, %8 offset:%16"
                     : "=&v"(lo[0]), "=&v"(lo[1]), "=&v"(lo[2]), "=&v"(lo[3]), "=&v"(hi[0]), "=&v"(hi[1]), "=&v"(hi[2]), "=&v"(hi[3])
                     : "v"(vb), "n"(T0 * 2304), "n"(T0 * 2304 + 32), "n"(T0 * 2304 + 64), "n"(T0 * 2304 + 96), "n"(T1 * 2304), "n"(T1 * 2304 + 32), "n"(T1 * 2304 + 64), "n"(T1 * 2304 + 96) : "memory");
    } else {
        if constexpr (WAIT)
        asm volatile("ds_read_b64_tr_b16 %0, %2 offset:%3\n\tds_read_b64_tr_b16 %1, %2 offset:%4\n\ts_waitcnt lgkmcnt(0)"
                     : "=&v"(lo[0]), "=&v"(hi[0]) : "v"(vb), "n"(T0 * 2304), "n"(T1 * 2304) : "memory");
        else
        asm volatile("ds_read_b64_tr_b16 %0, %2 offset:%3\n\tds_read_b64_tr_b16 %1, %2 offset:%4"
                     : "=&v"(lo[0]), "=&v"(hi[0]) : "v"(vb), "n"(T0 * 2304), "n"(T1 * 2304) : "memory");
    }
}
template <int NDT, int U>
__device__ __forceinline__ void pv_mma(const f32x4 (&s)[9], const s16x4 (&lo)[NDT], const s16x4 (&hi)[NDT], f32x4 (&o)[NDT]) {
    constexpr int T0 = 2 * U, T1 = (2 * U + 1 < 9) ? 2 * U + 1 : 2 * U;
    u32x4 pw; pw.x = pk2(s[T0][0], s[T0][1]); pw.y = pk2(s[T0][2], s[T0][3]);
    if constexpr (2 * U + 1 < 9) { pw.z = pk2(s[T1][0], s[T1][1]); pw.w = pk2(s[T1][2], s[T1][3]); } else { pw.z = 0u; pw.w = 0u; }
    const bf16x8 pf = __builtin_bit_cast(bf16x8, pw);
#pragma unroll
    for (int d = 0; d < NDT; ++d) { const bf16x8 vf = __builtin_shufflevector(lo[d], hi[d], 0, 1, 2, 3, 4, 5, 6, 7); o[d] = MFMA16(vf, pf, o[d]); }
}
template <int NDT>
__device__ __forceinline__ void attn_core(const bf16x8 q0, const bf16x8 q1, const LAS unsigned char* Kl, unsigned vbase, int kt0, int qkey, int tmin, float sinkv, const LAS float* brow, int dt0, int fr, int fq, f32x4 (&o)[NDT]) {
    f32x4 s[9];
    const LAS unsigned char* kp = Kl + (16 * kt0 + fr) * 144 + fq * 16;
#pragma unroll
    for (int t = 0; t < 9; ++t) {
        const bf16x8 k0 = *(const LAS bf16x8*)(kp + t * 2304), k1 = *(const LAS bf16x8*)(kp + t * 2304 + 64);
        f32x4 a = (f32x4){0.f, 0.f, 0.f, 0.f};
        a = MFMA16(k0, q0, a); a = MFMA16(k1, q1, a);
        s[t] = a;
    }
    float mx = sinkv;
    const LAS float* bp = brow + (qkey - 16 * kt0 - 4 * fq + 16 - 3 - 128);
#pragma unroll
    for (int t = 0; t < 9; ++t) {
        const float tp = (kt0 + t < tmin) ? -1e30f : 0.f;
#pragma unroll
        for (int jj = 0; jj < 4; ++jj) { const float v = s[t][jj] + bp[128 - 16 * t + 3 - jj] + tp; s[t][jj] = v; mx = fmaxf(mx, v); }
    }
    mx = fmaxf(mx, __shfl_xor(mx, 16)); mx = fmaxf(mx, __shfl_xor(mx, 32));
    float l = 0.f;
#pragma unroll
    for (int t = 0; t < 9; ++t)
#pragma unroll
        for (int jj = 0; jj < 4; ++jj) { const float p = fexp(s[t][jj] - mx); s[t][jj] = p; l += p; }
    l += __shfl_xor(l, 16); l += __shfl_xor(l, 32);
    l += fexp(sinkv - mx);
    const float inv = __builtin_amdgcn_rcpf(l);
#pragma unroll
    for (int d = 0; d < NDT; ++d) o[d] = (f32x4){0.f, 0.f, 0.f, 0.f};
    const unsigned vb = vbase + (unsigned)((16 * kt0 + 4 * fq + (fr >> 2)) * 144 + 32 * dt0 + 8 * (fr & 3));
    {
        s16x4 l0[NDT], h0[NDT], l1[NDT], h1[NDT], l2[NDT], h2[NDT];
        v_read<NDT, 0, false>(vb, l0, h0); v_read<NDT, 1, false>(vb, l1, h1); v_read<NDT, 2, true>(vb, l2, h2); __builtin_amdgcn_sched_barrier(0);
        pv_mma<NDT, 0>(s, l0, h0, o); pv_mma<NDT, 1>(s, l1, h1, o); pv_mma<NDT, 2>(s, l2, h2, o);
        v_read<NDT, 3, false>(vb, l0, h0); v_read<NDT, 4, true>(vb, l1, h1); __builtin_amdgcn_sched_barrier(0);
        pv_mma<NDT, 3>(s, l0, h0, o); pv_mma<NDT, 4>(s, l1, h1, o);
    }
#pragma unroll
    for (int d = 0; d < NDT; ++d) o[d] = o[d] * inv;
}
constexpr int P2_K_OFF = 0, P2_V_OFF = 41472, P2_BIAS_OFF = 82944;
__device__ __forceinline__ void p2_bias_table(LAS unsigned char* lds, int tid) {
    const float* relb = karg<I_RELB>(); const float* sinks = karg<I_SINKS>();
    LAS float* bt = (LAS float*)(lds + P2_BIAS_OFF);
    for (int i = tid; i < 8 * 160; i += 512) { const int h = i / 160, d = i % 160 - 16; bt[i] = (d >= 0 && d <= 128) ? relb[rel_bucket(d) * 8 + h] : -1e30f; }
    if (tid < 8) bt[8 * 160 + tid] = sinks[tid];
    LDS_WAIT(); __syncthreads();
}
__device__ __forceinline__ void attn_prompt_item(const Ctx& C, LAS unsigned char* lds, unsigned ldsbase, int item, int tid, int wid, int lane) {
    const int kvh = item & 1, nb = (item >> 1) & 15, b = item >> 5, fr = lane & 15, fq = lane >> 4;
    __syncthreads();
#pragma unroll
    for (int i = 0; i < 4; ++i) { const int idx = tid + 512 * i, j = idx >> 3, ch = idx & 7, t = 128 * (nb - 1) + j;
        u32x4 kv = (u32x4){0u, 0u, 0u, 0u}, vv = (u32x4){0u, 0u, 0u, 0u};
        if (t >= 0) { const size_t off = (size_t)t * KVW + kvh * 64 + 8 * ch; kv = *(const u32x4*)(WSG(const bf16, WS_K, LR(b * SEQ)) + off); vv = *(const u32x4*)(WSG(const bf16, WS_V, LR(b * SEQ)) + off); }
        *(LAS u32x4*)(lds + P2_K_OFF + j * 144 + 16 * ch) = kv; *(LAS u32x4*)(lds + P2_V_OFF + j * 144 + 16 * ch) = vv; }
    LDS_WAIT(); __syncthreads();
    const LAS float* bt = (const LAS float*)(lds + P2_BIAS_OFF);
    const int rowb = LR(b * SEQ + nb * 128), row = row_loc(rowb) + 16 * wid + fr;
#pragma unroll 1
    for (int g = 0; g < 4; ++g) {
        const int h = 4 * kvh + g;
        const bf16* qp = WSG(const bf16, WS_QA, rowb) + (size_t)row * QW + h * 64 + 8 * fq;
        const bf16x8 q0 = *(const bf16x8*)qp, q1 = *(const bf16x8*)(qp + 32);
        f32x4 o[4];
        attn_core<4>(q0, q1, lds + P2_K_OFF, ldsbase + P2_V_OFF, wid, 128 + 16 * wid + fr, nb == 0 ? 8 : 0, bt[8 * 160 + h], bt + h * 160, 0, fr, fq, o);
        bf16* op = WSG(bf16, WS_QA, rowb) + (size_t)row * QW + h * 64 + 4 * fq;
#pragma unroll
        for (int d = 0; d < 4; ++d) { u32x2 w; w.x = pk2(o[d][0], o[d][1]); w.y = pk2(o[d][2], o[d][3]); *(u32x2*)(op + 16 * d) = w; }
    }
}
__device__ __forceinline__ void attn_sample_item(const Ctx& C, LAS unsigned char* lds, unsigned ldsbase, int b, int tid, int wid, int lane) {
    const int fr = lane & 15, fq = lane >> 4;
    const float* ck = karg<I_CK>(); const float* cv = karg<I_CV>();
    __syncthreads();
    for (int idx = tid; idx < 144 * 32; idx += 512) { const int j = idx >> 5, c4 = idx & 31, kvh = c4 >> 4, d0 = (c4 & 15) * 4;
        f32x4 kf = (f32x4){0.f, 0.f, 0.f, 0.f}, vf = (f32x4){0.f, 0.f, 0.f, 0.f};
        if (j < 128) { const size_t off = ((size_t)(b * 128 + j) * 2 + kvh) * 64 + d0; kf = *(const f32x4*)(ck + off); vf = *(const f32x4*)(cv + off); }
        else if (j < 132) { const int lr_ = LR(MP + 4 * b); const size_t off = (size_t)(row_loc(lr_) + j - 128) * KVW + kvh * 64 + d0; const u32x2 kw = *(const u32x2*)(WSG(const bf16, WS_K, lr_) + off), vw = *(const u32x2*)(WSG(const bf16, WS_V, lr_) + off);
            kf = (f32x4){bflo(kw.x), bfhi(kw.x), bflo(kw.y), bfhi(kw.y)}; vf = (f32x4){bflo(vw.x), bfhi(vw.x), bflo(vw.y), bfhi(vw.y)}; }
        u32x2 kw, vw; kw.x = pk2(kf[0], kf[1]); kw.y = pk2(kf[2], kf[3]); vw.x = pk2(vf[0], vf[1]); vw.y = pk2(vf[2], vf[3]);
        *(LAS u32x2*)(lds + P2_K_OFF + (kvh * 144 + j) * 144 + 2 * d0) = kw; *(LAS u32x2*)(lds + P2_V_OFF + (kvh * 144 + j) * 144 + 2 * d0) = vw; }
    const int kvh = wid >> 2, dt = wid & 3, i = fr >> 2, g = fr & 3, h = 4 * kvh + g, rowb = LR(MP + 4 * b), row = row_loc(rowb) + i;
    const bf16* qp = WSG(const bf16, WS_QA, rowb) + (size_t)row * QW + h * 64 + 8 * fq;
    const bf16x8 q0 = *(const bf16x8*)qp, q1 = *(const bf16x8*)(qp + 32);
    VM_WAIT(); LDS_WAIT(); __syncthreads();
    const LAS float* bt = (const LAS float*)(lds + P2_BIAS_OFF);
    f32x4 o[1];
    attn_core<1>(q0, q1, lds + P2_K_OFF + kvh * 144 * 144, ldsbase + P2_V_OFF + kvh * 144 * 144, 0, 128 + i, 0, bt[8 * 160 + h], bt + h * 160, dt, fr, fq, o);
    u32x2 w; w.x = pk2(o[0][0], o[0][1]); w.y = pk2(o[0][2], o[0][3]);
    *(u32x2*)(WSG(bf16, WS_QA, rowb) + (size_t)row * QW + h * 64 + 16 * dt + 4 * fq) = w;
}

constexpr int RG_XC_OFF = 0, RG_HS_OFF = 36864, RG_TOT_OFF = 36864 + 69632;
__device__ __forceinline__ void rg_gate(float rp, float ip, float xv, float ba, float bx, float csp, float& a, float& bt) {
    const float r = fsigmoid(rp + ba), i = fsigmoid(ip + bx), la = csp * r;
    a = fexp(la);
    const float x2 = la + la;
    const float tay = -x2 * (1.f + x2 * 0.5f * (1.f + x2 * (1.f / 3.f) * (1.f + x2 * 0.25f * (1.f + x2 * 0.2f * (1.f + x2 * (1.f / 6.f))))));
    const float om = x2 > -0.25f ? tay : 1.f - a * a;
    bt = __builtin_amdgcn_sqrtf(om) * (i * xv);
}
struct RgW { bf16x8 wa[2], wx[2], idf[2]; float ba, bx, csp; };
__device__ __forceinline__ void rg_load_w(const Ctx& C, RgW& w, int cb, int eg, int fr, int fq) {
    const bf16* pa = WSP(const bf16, WS_WRGA) + (size_t)(cb * 64 + 16 * eg + fr) * 64 + 8 * fq;
    const bf16* px = WSP(const bf16, WS_WRGX) + (size_t)(cb * 64 + 16 * eg + fr) * 64 + 8 * fq;
#pragma unroll
    for (int ks = 0; ks < 2; ++ks) { w.wa[ks] = *(const bf16x8*)(pa + 32 * ks); w.wx[ks] = *(const bf16x8*)(px + 32 * ks);
        bf16x8 id;
#pragma unroll
        for (int jj = 0; jj < 8; ++jj) id[jj] = (32 * ks + 8 * fq + jj == 16 * eg + fr) ? (short)0x3F80 : (short)0;
        w.idf[ks] = id; }
    const int ch = 64 * cb + 16 * eg + fr;
    w.ba = karg<I_RGBA>()[ch]; w.bx = karg<I_RGBX>()[ch];
    w.csp = -8.0f * log1pf(__expf(-karg<I_RGLAM>()[ch]));
}
__device__ __forceinline__ void rglru_prompt_loop(const Ctx& C, LAS unsigned char* lds, int tid, int wid, int lane) {
    int item = (C.G == 128) ? 64 * (C.c >> 6) + 16 * (C.c & 3) + ((C.c >> 2) & 15) : C.c; if (item >= 512) return;
    const int fr = lane & 15, fq = lane >> 4, eg = wid & 3, th = wid >> 2, o8 = tid & 7, tq = tid >> 3;
    LAS unsigned char* XC = lds + RG_XC_OFF; LAS float* HS = (LAS float*)(lds + RG_HS_OFF); LAS float* TOT = (LAS float*)(lds + RG_TOT_OFF);
    unsigned long long* agg = WSP(unsigned long long, WS_AGG);
    unsigned* flags = WSP(unsigned, WS_FLAGS);
    RgW W; f32x4 cw[4][2], cbv[2]; int cur_bcb = -1;
    u32x4 xr[7], gr[4];
#define RG_LOAD_XR(it) do { const int _c = (it) >> 6, _b = 4 * C.dom + (((it) >> 4) & 3), _cb = (it) & 15; \
        _Pragma("unroll") for (int j = 0; j < 7; ++j) { const int tt = _c * 256 + 4 * tq - 3 + j; \
            xr[j] = *(const u32x4*)(WSG(const bf16, WS_XR, LR(_b * SEQ)) + (size_t)(tt < 0 ? 0 : tt) * D + 64 * _cb + 8 * o8); } } while (0)
#define RG_LOAD_GR(it) do { const int _c = (it) >> 6, _b = 4 * C.dom + (((it) >> 4) & 3), _cb = (it) & 15; \
        _Pragma("unroll") for (int q = 0; q < 4; ++q) gr[q] = *(const u32x4*)(WSG(const bf16, WS_GR, LR(_b * SEQ)) + (size_t)(_c * 256 + 4 * tq + q) * D + 64 * _cb + 8 * o8); } while (0)
    RG_LOAD_XR(item); RG_LOAD_GR(item);
#pragma unroll 1
    for (;;) {
        const int cidx = item >> 6, b = 4 * C.dom + ((item >> 4) & 3), cb = item & 15, bcb = b * 16 + cb, ch = 64 * cb + 16 * eg + fr, t0 = cidx * 256;
        const int nitem = item + C.G;
        if (bcb != cur_bcb) {
            cur_bcb = bcb; rg_load_w(C, W, cb, eg, fr, fq);
            const float* convw = karg<I_CONVW>() + 64 * cb + 8 * o8; const float* convb = karg<I_CONVB>() + 64 * cb + 8 * o8;
            cbv[0] = *(const f32x4*)convb; cbv[1] = *(const f32x4*)(convb + 4);
#pragma unroll
            for (int j = 0; j < 4; ++j) { cw[j][0] = *(const f32x4*)(convw + j * D); cw[j][1] = *(const f32x4*)(convw + j * D + 4); }
        }
        __syncthreads();
        {
            f32x4 xf[7][2];
#pragma unroll
            for (int j = 0; j < 7; ++j) { const float z = (t0 + 4 * tq - 3 + j >= 0) ? 1.f : 0.f; const u32x4 xv = xr[j];
                xf[j][0] = (f32x4){bflo(xv.x), bfhi(xv.x), bflo(xv.y), bfhi(xv.y)} * z; xf[j][1] = (f32x4){bflo(xv.z), bfhi(xv.z), bflo(xv.w), bfhi(xv.w)} * z; }
#pragma unroll
            for (int q = 0; q < 4; ++q) {
                f32x4 x0 = cbv[0], x1 = cbv[1];
#pragma unroll
                for (int j = 0; j < 4; ++j) { x0 += cw[j][0] * xf[q + j][0]; x1 += cw[j][1] * xf[q + j][1]; }
                u32x4 w; w.x = pk2(x0[0], x0[1]); w.y = pk2(x0[2], x0[3]); w.z = pk2(x1[0], x1[1]); w.w = pk2(x1[2], x1[3]);
                *(LAS u32x4*)(XC + (4 * tq + q) * 144 + 16 * o8) = w;
            }
        }
        LDS_WAIT(); __syncthreads();
        if (nitem < 512) RG_LOAD_XR(nitem);
        float av[2][4][4], bv[2][4][4], Ae[2], Be[2], Ag[2], Bg[2];
#pragma unroll
        for (int g2 = 0; g2 < 2; ++g2) {
            float Ai = 1.f, Bi = 0.f;
            const LAS unsigned char* ap = XC + (128 * th + 64 * g2 + 16 * (fr >> 2) + (fr & 3)) * 144 + 16 * fq;
#pragma unroll
            for (int m = 0; m < 4; ++m) {
                const bf16x8 a0 = *(const LAS bf16x8*)(ap + m * 576), a1 = *(const LAS bf16x8*)(ap + m * 576 + 64);
                f32x4 rp = (f32x4){0.f, 0.f, 0.f, 0.f}, ip = rp, xv = rp;
                rp = MFMA16(a0, W.wa[0], rp); rp = MFMA16(a1, W.wa[1], rp);
                ip = MFMA16(a0, W.wx[0], ip); ip = MFMA16(a1, W.wx[1], ip);
                xv = MFMA16(a0, W.idf[0], xv); xv = MFMA16(a1, W.idf[1], xv);
#pragma unroll
                for (int jj = 0; jj < 4; ++jj) { rg_gate(rp[jj], ip[jj], xv[jj], W.ba, W.bx, W.csp, av[g2][m][jj], bv[g2][m][jj]); Bi = av[g2][m][jj] * Bi + bv[g2][m][jj]; Ai *= av[g2][m][jj]; }
            }
            { const float Ap = __shfl_up(Ai, 16), Bp = __shfl_up(Bi, 16); if (fq >= 1) { Bi = Ai * Bp + Bi; Ai = Ai * Ap; } }
            { const float Ap = __shfl_up(Ai, 32), Bp = __shfl_up(Bi, 32); if (fq >= 2) { Bi = Ai * Bp + Bi; Ai = Ai * Ap; } }
            { const float Ap = __shfl_up(Ai, 16), Bp = __shfl_up(Bi, 16); Ae[g2] = fq ? Ap : 1.f; Be[g2] = fq ? Bp : 0.f; }
            Ag[g2] = __shfl(Ai, 48 + fr); Bg[g2] = __shfl(Bi, 48 + fr);
        }
        const float Aw = Ag[1] * Ag[0], Bw = Ag[1] * Bg[0] + Bg[1];
        if (fq == 0) { TOT[(th * 64 + 16 * eg + fr) * 2] = Aw; TOT[(th * 64 + 16 * eg + fr) * 2 + 1] = Bw; }
        LDS_WAIT(); __syncthreads();
        const float A0 = TOT[(16 * eg + fr) * 2], B0 = TOT[(16 * eg + fr) * 2 + 1], A1 = TOT[(64 + 16 * eg + fr) * 2], B1 = TOT[(64 + 16 * eg + fr) * 2 + 1];
        if (th == 1 && fq == 0) { const float Ac = A1 * A0, Hc = A1 * B0 + B1;
            __hip_atomic_store(agg + (size_t)(cidx * 128 + bcb) * 64 + 16 * eg + fr, ((unsigned long long)__float_as_uint(Hc) << 32) | __float_as_uint(Ac), __ATOMIC_RELAXED, __HIP_MEMORY_SCOPE_AGENT); }
        VM_WAIT(); __syncthreads();
        if (tid == 0) __hip_atomic_store(flags + cidx * 128 + bcb, 1u, __ATOMIC_RELAXED, __HIP_MEMORY_SCOPE_AGENT);
        float hc = 0.f;
        if (cidx > 0) {
            unsigned sp = 0;
            for (;;) { const unsigned f = (lane < cidx) ? __hip_atomic_load(flags + lane * 128 + bcb, __ATOMIC_RELAXED, __HIP_MEMORY_SCOPE_AGENT) : 1u;
                if (__all(f != 0u)) break;
                __builtin_amdgcn_s_sleep(1); if (++sp > (1u << 20)) break; }
            unsigned long long w[7];
#pragma unroll
            for (int j = 0; j < 7; ++j) w[j] = (j < cidx) ? __hip_atomic_load(agg + (size_t)(j * 128 + bcb) * 64 + 16 * eg + fr, __ATOMIC_RELAXED, __HIP_MEMORY_SCOPE_AGENT) : 0ull;
#pragma unroll
            for (int j = 0; j < 7; ++j) if (j < cidx) hc = __uint_as_float((unsigned)w[j]) * hc + __uint_as_float((unsigned)(w[j] >> 32));
        }
        const float hmid = A0 * hc + B0;
        float hin = th ? hmid : hc;
#pragma unroll
        for (int g2 = 0; g2 < 2; ++g2) {
            float hl = Ae[g2] * hin + Be[g2];
#pragma unroll
            for (int m = 0; m < 4; ++m)
#pragma unroll
                for (int jj = 0; jj < 4; ++jj) { hl = av[g2][m][jj] * hl + bv[g2][m][jj]; HS[(128 * th + 64 * g2 + 16 * fq + 4 * m + jj) * 68 + 16 * eg + fr] = hl; }
            hin = Ag[g2] * hin + Bg[g2];
        }
        if (cidx == 7 && th == 0 && fq == 0) C.out[O_HP + (size_t)b * D + ch] = A1 * hmid + B1;
        LDS_WAIT(); __syncthreads();
#pragma unroll
        for (int q = 0; q < 4; ++q) {
            const int tl = 4 * tq + q;
            const f32x4 h0 = *(const LAS f32x4*)(HS + tl * 68 + 8 * o8), h1 = *(const LAS f32x4*)(HS + tl * 68 + 8 * o8 + 4);
            const u32x4 g = gr[q];
            st_bf16x8(WSG(bf16, WS_GR, LR(b * SEQ)) + (size_t)(t0 + tl) * D + 64 * cb + 8 * o8, h0 * (f32x4){bflo(g.x), bfhi(g.x), bflo(g.y), bfhi(g.y)}, h1 * (f32x4){bflo(g.z), bfhi(g.z), bflo(g.w), bfhi(g.w)});
        }
        if (nitem >= 512) break;
        RG_LOAD_GR(nitem);
        item = nitem;
    }
#undef RG_LOAD_XR
#undef RG_LOAD_GR
}
__device__ __forceinline__ void rglru_sample_item(const Ctx& C, LAS unsigned char* lds, int cb, int bg, int tid, int wid, int lane) {
    const int fr = lane & 15, fq = lane >> 4, eg = wid & 3, th = wid >> 2, ch = 64 * cb + 16 * eg + fr;
    LAS unsigned char* XC = lds + RG_XC_OFF; LAS float* HS = (LAS float*)(lds + RG_HS_OFF);
    RgW W; rg_load_w(C, W, cb, eg, fr, fq);
    const int o8 = tid & 7, tl = tid >> 3, bb = 16 * bg + (tl >> 2), ii = tl & 3;
    __syncthreads();
    {
        const float* convw = karg<I_CONVW>(); const float* convb = karg<I_CONVB>(); const float* sconv = karg<I_SCONV>();
        float xc[8];
#pragma unroll
        for (int e = 0; e < 8; ++e) xc[e] = convb[64 * cb + 8 * o8 + e];
#pragma unroll
        for (int j = 0; j < 4; ++j) { const int tt = ii - 3 + j; float xin[8];
            if (tt >= 0) { const u32x4 xv = *(const u32x4*)(WSG(const bf16, WS_XR, LR(MP + 64 * bg)) + (size_t)(2048 + 4 * (tl >> 2) + tt) * D + 64 * cb + 8 * o8);
                xin[0] = bflo(xv.x); xin[1] = bfhi(xv.x); xin[2] = bflo(xv.y); xin[3] = bfhi(xv.y); xin[4] = bflo(xv.z); xin[5] = bfhi(xv.z); xin[6] = bflo(xv.w); xin[7] = bfhi(xv.w); }
            else { const float* sp = sconv + (size_t)(bb * 3 + ii + j) * D + 64 * cb + 8 * o8; const f32x4 s0 = *(const f32x4*)sp, s1 = *(const f32x4*)(sp + 4);
                xin[0] = s0[0]; xin[1] = s0[1]; xin[2] = s0[2]; xin[3] = s0[3]; xin[4] = s1[0]; xin[5] = s1[1]; xin[6] = s1[2]; xin[7] = s1[3]; }
            const f32x4 w0 = *(const f32x4*)(convw + j * D + 64 * cb + 8 * o8), w1 = *(const f32x4*)(convw + j * D + 64 * cb + 8 * o8 + 4);
#pragma unroll
            for (int e = 0; e < 4; ++e) { xc[e] += w0[e] * xin[e]; xc[4 + e] += w1[e] * xin[4 + e]; } }
        u32x4 w; w.x = pk2(xc[0], xc[1]); w.y = pk2(xc[2], xc[3]); w.z = pk2(xc[4], xc[5]); w.w = pk2(xc[6], xc[7]);
        *(LAS u32x4*)(XC + tl * 144 + 16 * o8) = w;
    }
    LDS_WAIT(); __syncthreads();
    {
        const float* sh = karg<I_SH>();
#pragma unroll
        for (int mm = 0; mm < 2; ++mm) {
            const int m = 2 * th + mm, bq = 16 * bg + 4 * m + fq;
            const LAS unsigned char* ap = XC + (16 * m + fr) * 144 + 16 * fq;
            const bf16x8 a0 = *(const LAS bf16x8*)ap, a1 = *(const LAS bf16x8*)(ap + 64);
            f32x4 rp = (f32x4){0.f, 0.f, 0.f, 0.f}, ip = rp, xv = rp;
            rp = MFMA16(a0, W.wa[0], rp); rp = MFMA16(a1, W.wa[1], rp);
            ip = MFMA16(a0, W.wx[0], ip); ip = MFMA16(a1, W.wx[1], ip);
            xv = MFMA16(a0, W.idf[0], xv); xv = MFMA16(a1, W.idf[1], xv);
            float h = sh[(size_t)bq * D + ch];
#pragma unroll
            for (int jj = 0; jj < 4; ++jj) { float a, bt; rg_gate(rp[jj], ip[jj], xv[jj], W.ba, W.bx, W.csp, a, bt); h = a * h + bt; HS[(16 * m + 4 * fq + jj) * 68 + 16 * eg + fr] = h; }
            C.out[O_HS + (size_t)bq * D + ch] = h;
        }
    }
    LDS_WAIT(); __syncthreads();
    {
        const f32x4 h0 = *(const LAS f32x4*)(HS + tl * 68 + 8 * o8), h1 = *(const LAS f32x4*)(HS + tl * 68 + 8 * o8 + 4);
        bf16* gp = WSG(bf16, WS_GR, LR(MP + 64 * bg)) + (size_t)(2048 + tl) * D + 64 * cb + 8 * o8;
        f32x4 g0, g1; ld_bf16x8(gp, g0, g1);
        st_bf16x8(gp, h0 * g0, h1 * g1);
    }
}
__device__ __forceinline__ void p2_phase(const Ctx& C, LAS unsigned char* lds, unsigned ldsbase, unsigned* scnt, int tid, int wid, int lane) {
    rglru_prompt_loop(C, lds, tid, wid, lane);
    __syncthreads();
    p2_bias_table(lds, tid);
#pragma unroll 1
    for (int it = C.c; it < 128; it += C.G) { const int itg = (C.G == 128) ? 32 * (it & 3) + (it >> 2) : it;
        attn_prompt_item(C, lds, ldsbase, (4 * C.dom + (itg >> 5)) * 32 + (itg & 31), tid, wid, lane); }
    if (tid == 0) { unsigned sp = 0; while (__hip_atomic_load(scnt, __ATOMIC_RELAXED, __HIP_MEMORY_SCOPE_AGENT) < 19u) { __builtin_amdgcn_s_sleep(2); if (++sp > (1u << 22)) break; }
        __builtin_amdgcn_fence(__ATOMIC_ACQUIRE, "agent"); VM_WAIT(); }
    __syncthreads();
    for (int vb0 = C.c; vb0 < 128; vb0 += C.G) {
        const int vb = (C.G == 128) ? (((vb0 >> 2) < 16) ? 16 * (vb0 & 3) + (vb0 >> 2) : 64 + 16 * (vb0 & 3) + ((vb0 >> 2) - 16)) : vb0;
        if (vb >= 64) attn_sample_item(C, lds, ldsbase, 64 * C.dom + vb - 64, tid, wid, lane);
        else { __syncthreads(); rglru_sample_item(C, lds, vb & 15, 4 * C.dom + (vb >> 4), tid, wid, lane); }
    }
    __syncthreads();
}

__global__ void __launch_bounds__(512, 2) mk_fwd(Args args) {
    extern __shared__ __attribute__((aligned(16))) unsigned char lds_raw[];
    LAS unsigned char* lds = (LAS unsigned char*)lds_raw;
    const unsigned ldsbase = (unsigned)(size_t)lds_raw;
    const int wid = __builtin_amdgcn_readfirstlane((int)threadIdx.x >> 6);
#define FRESH_IDS const int lane = lane_fresh(), tid = wid * 64 + lane
    Ctx C;
    C.out = args.out; C.ws = args.ws; C.p0 = nullptr; C.p1 = nullptr;
    const int NG = gridDim.x;
    C.G = NG >> 1; C.c = blockIdx.x >> 1; C.dom = blockIdx.x & 1;
    C.wd = args.ws + WS_ACT + (size_t)C.dom * DOM_STRIDE;
    const int vcu = (NG % 8 == 0) ? (int)(blockIdx.x % 8) * (NG / 8) + (int)blockIdx.x / 8 : (int)blockIdx.x;
    { FRESH_IDS; for (int u = tid; u < (LDS_BYTES - 131072) / 4; u += 512) ((LAS unsigned*)(lds + 131072))[u] = 0u; }
    __syncthreads();
    const int lo = args.ph_lo, hi = args.ph_hi;
    unsigned* bar_all = (unsigned*)(args.ws + WS_CTL);
    unsigned* bar = bar_all + XCD_BAR_WORDS * (1 + C.dom);
    unsigned* ev = bar_all + 64;
    volatile LAS unsigned* bst_all = (volatile LAS unsigned*)(lds + MISC_OFF) + 8;
    volatile LAS unsigned* bst = (volatile LAS unsigned*)(lds + MISC_OFF) + 12;
    const bool grp = (C.G == 128);
    unsigned* gbar = (unsigned*)(args.ws + WS_GBAR) + XCD_BAR_WORDS * (4 * C.dom + (C.c & 3));
    volatile LAS unsigned* bst_g = (volatile LAS unsigned*)(lds + MISC_OFF) + 16;
    if (hi - lo > 1) { xcd_barrier_post(bar_all, wid); xcd_barrier_post(bar, wid); if (grp) xcd_barrier_post(gbar, wid); }
#define IN(k) (lo <= (k) && (k) < hi)
#define SEAM(k) do { if (IN(k) && IN((k) + 1)) xcd_barrier(bar, bst, (unsigned)C.G, wid); } while (0)
#define GSEAM(k) do { if (IN(k) && IN((k) + 1)) { if (grp) xcd_barrier(gbar, bst_g, 32u, wid, true); else xcd_barrier(bar, bst, (unsigned)C.G, wid); } } while (0)
    if (IN(0)) {
        { FRESH_IDS; p0a_prologue(C, lds, vcu, NG, tid, wid, lane); }
        if (IN(1)) xcd_barrier(bar_all, bst_all, (unsigned)NG, wid);
        if (grp) {
            const int q = 4 * C.dom + (C.c & 3);
            const int st = q <= 1 ? 0 : q == 2 ? 123 : q == 3 ? 390 : q == 4 ? 830 : q == 5 ? 1484 : q == 6 ? 2424 : 3794;
            const int en = q == 0 ? 0 : q == 1 ? 123 : q == 2 ? 390 : q == 3 ? 830 : q == 4 ? 1484 : q == 5 ? 2424 : q == 6 ? 3794 : (1 << 30);
            if (q > 0) {
                { FRESH_IDS; p0b_prologue(C, lds, C.c >> 2, 32, st, en, tid, wid, lane); }
                VM_WAIT(); __syncthreads();
                if (wid == 0 && lane_fresh() == 0) __hip_atomic_fetch_add(ev, 1u, __ATOMIC_RELAXED, __HIP_MEMORY_SCOPE_AGENT);
            }
        } else if (C.dom == 1) {
            { FRESH_IDS; p0b_prologue(C, lds, C.c, C.G, 0, 1 << 30, tid, wid, lane); }
            VM_WAIT(); __syncthreads();
            if (wid == 0 && lane_fresh() == 0) __hip_atomic_fetch_add(ev, 1u, __ATOMIC_RELAXED, __HIP_MEMORY_SCOPE_AGENT);
        }
    }
    unsigned* scnt = bar_all + 80 + C.dom;
    if (IN(1)) { C.p0 = karg<I_QG>(); C.p1 = karg<I_KG>();
        const int ns = gemm_phase<PH_IN>(lds, C, wid);
        if (ns > 0 && wid == 0 && lane_fresh() == 0) __hip_atomic_fetch_add(scnt, (unsigned)ns, __ATOMIC_RELAXED, __HIP_MEMORY_SCOPE_AGENT);
        GSEAM(1); }
    if (IN(2)) { { FRESH_IDS; p2_phase(C, lds, ldsbase, scnt, tid, wid, lane); } GSEAM(2); }
    if (IN(3) && IN(0)) {
        if (wid == 0 && lane_fresh() == 0) { unsigned sp = 0; while (__hip_atomic_load(ev, __ATOMIC_RELAXED, __HIP_MEMORY_SCOPE_AGENT) < (grp ? 224u : (unsigned)C.G)) { __builtin_amdgcn_s_sleep(2); if (++sp > (1u << 22)) break; }
            __builtin_amdgcn_fence(__ATOMIC_ACQUIRE, "agent"); VM_WAIT(); }
        __syncthreads();
    }
    if (IN(3)) { gemm_phase<PH_MIX>(lds, C, wid); GSEAM(3); }
    if (IN(4)) { C.p0 = karg<I_XP>(); C.p1 = karg<I_XS>();
        gemm_phase<PH_OUT>(lds, C, wid); GSEAM(4); }
    if (IN(5)) {
        gemm_phase<PH_UP>(lds, C, wid);
        GSEAM(5); }
    if (IN(6)) { gemm_phase<PH_DOWN>(lds, C, wid); GSEAM(6); }
    if (IN(7)) { gemm_phase<PH_PLE>(lds, C, wid); if (C.dom == 0) { FRESH_IDS; cache_shift(C, C.c, C.G, tid); } }
#undef FRESH_IDS
#undef IN
#undef SEAM
#undef GSEAM
}

extern "C" void kernel_launch(void* const* d_in, const int* in_sizes, int n_in, void* d_out, int out_size, void* d_ws, size_t ws_size, hipStream_t stream) {
    static int grid = 0;
    if (grid == 0) {
        if (n_in != 30 || ws_size < WS_END) { fprintf(stderr, "kernel_launch: built for 30 inputs and >= %zu bytes of workspace; got n_in %d, ws %zu\n", (size_t)WS_END, n_in, ws_size); grid = -1; return; }
        int dev = 0, cus = 0, per_cu = 0;
        if (hipGetDevice(&dev) != hipSuccess || hipDeviceGetAttribute(&cus, hipDeviceAttributeMultiprocessorCount, dev) != hipSuccess) { grid = -1; return; }
        if (hipFuncSetAttribute((const void*)mk_fwd, hipFuncAttributeMaxDynamicSharedMemorySize, LDS_BYTES) != hipSuccess) { fprintf(stderr, "kernel_launch: hipFuncSetAttribute failed\n"); grid = -1; return; }
        if (hipOccupancyMaxActiveBlocksPerMultiprocessor(&per_cu, (const void*)mk_fwd, 512, LDS_BYTES) != hipSuccess || per_cu < 1) fprintf(stderr, "kernel_launch: occupancy query reports %d\n", per_cu);
        (void)hipGetLastError();
        grid = cus & ~1;
    }
    if (grid < 0) return;
    (void)hipMemsetAsync((char*)d_ws + WS_CTL, 0, CTL_ZERO_BYTES, stream);
    Args a{};
    for (int i = 0; i < 30; ++i) a.in[i] = (const float*)d_in[i];
    a.out = (float*)d_out; a.ws = (unsigned char*)d_ws;
#if MK_LAUNCHES == 1
    a.ph_lo = 0; a.ph_hi = 8;
    hipLaunchKernelGGL(mk_fwd, dim3(grid), dim3(512), LDS_BYTES, stream, a);
#else
    for (int ph = 0; ph < 8; ++ph) { a.ph_lo = ph; a.ph_hi = ph + 1; hipLaunchKernelGGL(mk_fwd, dim3(grid), dim3(512), LDS_BYTES, stream, a); }
#endif
}
```

```cpp
#include <hip/hip_runtime.h>
#include <cstdio>
#include <cstdint>

#ifndef MK_LAUNCHES
#define MK_LAUNCHES 1
#endif

#define LAS __attribute__((address_space(3)))
typedef unsigned short bf16;
typedef short bf16x8 __attribute__((ext_vector_type(8)));
typedef short s16x4 __attribute__((ext_vector_type(4)));
typedef float f32x4 __attribute__((ext_vector_type(4)));
typedef unsigned u32x4 __attribute__((ext_vector_type(4)));
typedef unsigned u32x2 __attribute__((ext_vector_type(2)));
typedef __bf16 bf16v2 __attribute__((ext_vector_type(2)));

constexpr int D = 1024, SEQ = 2048, NBAT = 8, MP = NBAT * SEQ, DB = 128, DS = 4, MS = DB * DS, M = MP + MS;
constexpr int QW = 512, KVW = 128, NIN = 4864, DFF = 4096, PLE = 256;
constexpr float EPS = 1e-6f;
constexpr size_t O_Y = 0, O_KP = (size_t)M * D, O_VP = O_KP + 8 * 128 * 128, O_CP = O_VP + 8 * 128 * 128, O_HP = O_CP + 8 * 3 * 1024,
                 O_KS = O_HP + 8 * 1024, O_VS = O_KS + (size_t)128 * 128 * 128, O_CS = O_VS + (size_t)128 * 128 * 128, O_HS = O_CS + 128 * 3 * 1024;
constexpr size_t MiB = 1u << 20;
constexpr size_t WS_CTL = 0, WS_FLAGS = 49152, WS_GBAR = 65536, CTL_ZERO_BYTES = 65536 + 8 * 13824;
constexpr size_t WS_WIN = 1 * MiB, WS_WOA = 11 * MiB, WS_WOR = 12 * MiB, WS_WOUT = 14 * MiB, WS_WUP = 16 * MiB, WS_WDN = 24 * MiB, WS_WPG = 32 * MiB,
                 WS_WPLE = 34 * MiB, WS_WRGA = 34 * MiB + 512 * 1024, WS_WRGX = 34 * MiB + 640 * 1024, WS_SS2 = 35 * MiB, WS_SS3 = 37 * MiB  , WS_AGG = 39 * MiB;
constexpr size_t WS_ACT = 40 * MiB, DOM_STRIDE = 108 * MiB;
constexpr size_t WS_QA = 40 * MiB, WS_K = 57 * MiB, WS_V = 62 * MiB;
constexpr size_t WS_X1B = 40 * MiB;
constexpr size_t WS_XR = 73 * MiB, WS_G2 = 73 * MiB, WS_PE = 73 * MiB;
constexpr size_t WS_PB = 106 * MiB;
constexpr size_t WS_XN = 124 * MiB, WS_MIX = 124 * MiB, WS_HMID = 124 * MiB;
constexpr size_t WS_GR = 157 * MiB, WS_SGA = 190 * MiB, WS_SGR = 223 * MiB, WS_END = 256 * MiB;
constexpr int LDS_BYTES = 147456, MISC_OFF = 131072 + 320;

__device__ __forceinline__ unsigned pk2(float lo, float hi) { bf16v2 v; v.x = (__bf16)lo; v.y = (__bf16)hi; return __builtin_bit_cast(unsigned, v); }
__device__ __forceinline__ float bflo(unsigned w) { return __builtin_bit_cast(float, w << 16); }
__device__ __forceinline__ float bfhi(unsigned w) { return __builtin_bit_cast(float, w & 0xffff0000u); }
__device__ __forceinline__ float fexp(float x) { return __builtin_amdgcn_exp2f(x * 1.44269504089f); }
__device__ __forceinline__ float fsigmoid(float x) { return __builtin_amdgcn_rcpf(1.0f + fexp(-x)); }
__device__ __forceinline__ f32x4 fsigmoid4(f32x4 x) { return (f32x4){fsigmoid(x[0]), fsigmoid(x[1]), fsigmoid(x[2]), fsigmoid(x[3])}; }
__device__ __forceinline__ float fgelu(float x) { const float u = x * x; return x * fsigmoid(x * (1.5957691216f + 0.0713548163f * u)); }
__device__ __forceinline__ float wave_sum(float v) {
#pragma unroll
    for (int o = 1; o < 64; o <<= 1) v += __shfl_xor(v, o);
    return v;
}
#define NT_LD(p) __builtin_nontemporal_load(p)
#define NT_ST(v, p) __builtin_nontemporal_store((v), (p))
__device__ __forceinline__ int lane_fresh() { int l; asm volatile("v_mbcnt_lo_u32_b32 %0, -1, 0\n\tv_mbcnt_hi_u32_b32 %0, -1, %0" : "=v"(l)); return l; }
#define LDS_WAIT() asm volatile("s_waitcnt lgkmcnt(0)" ::: "memory")
#define VM_WAIT() asm volatile("s_waitcnt vmcnt(0)" ::: "memory")
#define MFMA16(a, b, c) __builtin_amdgcn_mfma_f32_16x16x32_bf16((a), (b), (c), 0, 0, 0)

#define XB_TMO      128
#define XB_XCNT(j)  (256  + 64 * (j))
#define XB_XSUB(j)  (1280 + 64 * (j))
#define XB_XGEN(j)  (2304 + 64 * (j))
#define XB_TOP      3328
#define XB_TOPGEN   3392
#define XCD_BAR_WORDS 3456
#define XB_SPIN_CAP (1u << 18)
__device__ __forceinline__ unsigned xb_ld(unsigned* p)              { return __hip_atomic_load(p, __ATOMIC_RELAXED, __HIP_MEMORY_SCOPE_AGENT); }
__device__ __forceinline__ unsigned xb_add(unsigned* p, unsigned v) { return __hip_atomic_fetch_add(p, v, __ATOMIC_RELAXED, __HIP_MEMORY_SCOPE_AGENT); }
__device__ __forceinline__ unsigned xb_xcc_id() { return (unsigned)__builtin_amdgcn_s_getreg((3 << 11) | 20) & 0xFu; }
#define XB_SPIN(cond, bar) do { unsigned _sp = 0; while (cond) { __builtin_amdgcn_s_sleep(1); \
    if ((++_sp & 255u) == 0u) { if (xb_ld(&(bar)[XB_TMO])) break; if (_sp > XB_SPIN_CAP) { atomicAdd(&(bar)[XB_TMO], 1u); break; } } } } while (0)
__device__ __forceinline__ void xcd_barrier_post(unsigned* bar, int wid) { if (wid == 0 && lane_fresh() == 0) (void)xb_add(&bar[XB_XCNT(xb_xcc_id())], 1u); }
__device__ __forceinline__ void xcd_barrier_complete(unsigned* bar, unsigned x, unsigned& nloc, unsigned& nx, unsigned G) {
    unsigned sum, cnt, mine, sp = 0u;
    for (;;) {
        sum = 0u; cnt = 0u; mine = 0u;
#pragma unroll
        for (unsigned j = 0; j < 16; ++j) { const unsigned c = xb_ld(&bar[XB_XCNT(j)]); sum += c; cnt += (c > 0u) ? 1u : 0u; mine = (j == x) ? c : mine; }
        if (sum == G) break;
        __builtin_amdgcn_s_sleep(1);
        if ((++sp & 255u) == 0u) { if (xb_ld(&bar[XB_TMO])) break; if (sp > XB_SPIN_CAP) { atomicAdd(&bar[XB_TMO], 1u); break; } }
    }
    nloc = mine > 0u ? mine : 1u; nx = cnt > 0u ? cnt : 1u;
}
__device__ __forceinline__ void xcd_barrier(unsigned* bar, volatile LAS unsigned* st, unsigned ng, int wid, bool inner = false, bool skip_wb = false) {
    asm volatile("s_waitcnt vmcnt(0)" ::: "memory");
    __syncthreads();
    if (wid == 0 && lane_fresh() == 0) {
        const unsigned x = xb_xcc_id();
        __builtin_amdgcn_s_waitcnt(0);
        unsigned nloc = st[0], nx = st[1];
        if (nloc == 0u) { xcd_barrier_complete(bar, x, nloc, nx, ng); st[0] = nloc; st[1] = nx; }
        const unsigned k = st[2]; st[2] = k + 1u;
        const unsigned old = xb_add(&bar[XB_XSUB(x)], 1u);
        const unsigned gen = old / nloc;
        if (old + 1u == (gen + 1u) * nloc) {
            if (skip_wb || (inner && nx == 1u)) asm volatile("buffer_inv sc1\n\ts_waitcnt vmcnt(0)" ::: "memory");
            else asm volatile("buffer_wbl2 sc1\n\tbuffer_inv sc1\n\ts_waitcnt vmcnt(0)" ::: "memory");
            const unsigned og = xb_add(&bar[XB_TOP], 1u);
            const unsigned tg = og / nx;
            if (og + 1u == (tg + 1u) * nx) { xb_add(&bar[XB_TOPGEN], 1u); asm volatile("s_waitcnt vmcnt(0)" ::: "memory"); }
            else XB_SPIN(xb_ld(&bar[XB_TOPGEN]) == k, bar);
        } else {
            __builtin_amdgcn_fence(__ATOMIC_ACQUIRE, "agent");
            asm volatile("s_waitcnt vmcnt(0)" ::: "memory");
            XB_SPIN(xb_ld(&bar[XB_TOPGEN]) == k, bar);
        }
    }
    __syncthreads();
}

struct Args { const float* in[30]; float* out; unsigned char* ws; int ph_lo, ph_hi; };
template <int I> __device__ __forceinline__ const float* karg() {
    const float* p;
    asm volatile("s_load_dwordx2 %0, %1, %2\n\ts_waitcnt lgkmcnt(0)" : "=s"(p) : "s"(__builtin_amdgcn_kernarg_segment_ptr()), "n"(I * 8) : "memory");
    return p;
}
enum In { I_XP = 0, I_XS = 1, I_CK = 2, I_CV = 3, I_SCONV = 4, I_SH = 5, I_PP = 6, I_PS = 7, I_RELB = 8, I_N1G = 9, I_WIN = 10, I_QG = 11, I_KG = 12, I_SINKS = 13, I_WOA = 14, I_CONVW = 15, I_CONVB = 16,
          I_RGWA = 17, I_RGBA = 18, I_RGWX = 19, I_RGBX = 20, I_RGLAM = 21, I_WOR = 22, I_WOUT = 23, I_N2G = 24, I_WUP = 25, I_WDN = 26, I_PNG = 27, I_WPG = 28, I_WPLE = 29, I_OUT = 30, I_WS = 31 };
struct Ctx { float* out; unsigned char* ws; unsigned char* wd; const float* p0; const float* p1; int G, c, dom; };
#define WSP(T, off) ((T*)(C.ws + (off)))
constexpr size_t GRP_STRIDE = DOM_STRIDE / 4;
__device__ __forceinline__ int row_grp(int l) { return l < 8192 ? (l >> 11) : ((l - 8192) >> 6); }
__device__ __forceinline__ int row_loc(int l) { return l < 8192 ? (l & 2047) : 2048 + ((l - 8192) & 63); }
#define WSG(T, off, lrow) ((T*)(C.wd + (size_t)row_grp(lrow) * GRP_STRIDE + ((off) - WS_ACT) / 8))
#define LR(m) ((m) < MP ? (m) - 8192 * C.dom : (m) - (MP + 256 * C.dom - 8192))

constexpr int BM = 256, BK = 64, HALF = 128, HTB = HALF * BK * 2, NXCD = 8, WGM = 8;
__device__ __forceinline__ int lds_byte(int r, int c) { const int st = (r >> 4) * 2 + (c >> 5), rr = r & 15, cc = c & 31, ob = rr * 64 + cc * 2; return st * 1024 + (ob ^ (((ob >> 9) & 1) << 5)); }
__device__ __forceinline__ void stage_rc(int b, int& R, int& C) { const int st = b / 1024, sb = b % 1024, swz = sb ^ (((sb >> 9) & 1) << 5); R = (st >> 1) * 16 + swz / 64; C = (st & 1) * 32 + (swz % 64) / 2; }
__device__ __forceinline__ int perm32(int rho) { const int n = rho >> 4, i = rho & 15; return 8 * (i >> 2) + 4 * n + (i & 3); }

enum Kind { K_IN = 0, K_ATT = 1, K_RNN = 2, K_OUT = 3, K_PE = 4, K_UP = 5, K_DOWN = 6, K_PLE = 7, K_ATTS = 8, K_RNNS = 9 };
enum Phase { PH_IN = 1, PH_P2 = 2, PH_MIX = 3, PH_OUT = 4, PH_UP = 5, PH_DOWN = 6, PH_PLE = 7 };
struct Unit { const char* A; const char* B; int K; int kind; int row0; int lrow0; int col0; };

__device__ __forceinline__ void tile_order(int L, int nM, int nN, int& pm, int& pn) {
    constexpr int NX = 4;
    const int nwg = nM * nN; int wgid = L;
    { const int q = nwg / NX, r = nwg % NX, xcd = wgid % NX, off = wgid / NX; wgid = (xcd < r ? xcd * (q + 1) : r * (q + 1) + (xcd - r) * q) + off; }
    const int nig = WGM * nN, gid = wgid / nig, fm = gid * WGM, gsz = (nM - fm) < WGM ? (nM - fm) : WGM;
    pm = fm + ((wgid % nig) % gsz); pn = (wgid % nig) / gsz;
}
template <int PH> struct Sched {
    int G, c, dom; const char* ws; const char* wd;
    __device__ __forceinline__ bool next(int i, Unit& u) const {
        int pmd, pn;
        if constexpr (PH == PH_IN) {
            if (G == 128) {
                const int k = c & 3, j = c >> 2;
                const bool donor = (k == 1 && j >= 26 && j <= 28) || (k == 2 && j == 24), recv = (k == 1 && j >= 29) || (k == 2 && j == 29);
                if (i > 4) return false;
                int off = 32 * i + j;
                if (donor) { if (i == 4) return false; if (i == 3) off = 128 + j; }
                else if (recv) { if (i == 4) off = 96 + (k == 1 ? j - 3 : 24); }
                else if (off >= (k < 3 ? 157 : 156)) return false;
                if (off < 152) { pmd = 8 * k + (off & 7); pn = off >> 3; } else { pmd = 32; pn = 5 * k + (off - 152); }
            } else { const int L = i * G + c; if (L >= 33 * 19) return false; tile_order(L, 33, 19, pmd, pn); } }
        else if constexpr (PH == PH_MIX) { const int L = (i >> 1) * G + c; if (L >= 128) return false; tile_order(L, 32, 4, pmd, pn); }
        else if constexpr (PH == PH_OUT) { const int n1 = c < 128 ? (128 - c + G - 1) / G : 0; const int L = (i < n1 ? i : i - n1) * G + c; if (i >= n1 && L >= 128) return false; tile_order(L, 32, 4, pmd, pn); }
        else if constexpr (PH == PH_UP) { const int L = i * G + c; if (L >= 32 * 16) return false; tile_order(L, 32, 16, pmd, pn); }
        else { const int L = i * G + c; if (L >= 128) return false; tile_order(L, 32, 4, pmd, pn); }
        const int pm = pmd < 32 ? dom * 32 + pmd : 64 + dom;
        if constexpr (PH == PH_IN) { u.A = pmd < 32 ? wd + (size_t)(pmd >> 3) * GRP_STRIDE + (WS_XN - WS_ACT) / 8 + (size_t)(pmd & 7) * 256 * 1024 * 2 : wd + (WS_XN - WS_ACT) / 8 + (size_t)2048 * 1024 * 2;     u.B = ws + WS_WIN + (size_t)pn * 256 * 1024 * 2; u.K = 1024; u.kind = K_IN; }
        else if constexpr (PH == PH_MIX) {
            if ((i & 1) == 0) { u.A = wd + (size_t)(pmd >> 3) * GRP_STRIDE + (WS_QA - WS_ACT) / 8 + (size_t)(pmd & 7) * 256 * 512 * 2; u.B = ws + WS_WOA + (size_t)pn * 256 * 512 * 2; u.K = 512; u.kind = K_ATT; }
            else { u.A = wd + (size_t)(pmd >> 3) * GRP_STRIDE + (WS_GR - WS_ACT) / 8 + (size_t)(pmd & 7) * 256 * 1024 * 2; u.B = ws + WS_WOR + (size_t)pn * 256 * 1024 * 2; u.K = 1024; u.kind = K_RNN; } }
        else if constexpr (PH == PH_OUT) { const int n1 = c < 128 ? (128 - c + G - 1) / G : 0;
            if (i < n1) { u.A = wd + (size_t)(pmd >> 3) * GRP_STRIDE + (WS_MIX - WS_ACT) / 8 + (size_t)(pmd & 7) * 256 * 1024 * 2; u.B = ws + WS_WOUT + (size_t)pn * 256 * 1024 * 2; u.K = 1024; u.kind = K_OUT; }
            else { u.A = wd + (size_t)(pmd >> 3) * GRP_STRIDE + (WS_PB - WS_ACT) / 8 + (size_t)(pmd & 7) * 256 * 256 * 2; u.B = ws + WS_WPLE + (size_t)pn * 256 * 256 * 2; u.K = 256; u.kind = K_PE; } }
        else if constexpr (PH == PH_UP) { u.A = wd + (size_t)(pmd >> 3) * GRP_STRIDE + (WS_X1B - WS_ACT) / 8 + (size_t)(pmd & 7) * 256 * 1024 * 2; u.B = ws + WS_WUP + (size_t)pn * 256 * 1024 * 2; u.K = 1024; u.kind = K_UP; }
        else if constexpr (PH == PH_DOWN) { u.A = wd + (size_t)(pmd >> 3) * GRP_STRIDE + (WS_HMID - WS_ACT) / 8 + (size_t)(pmd & 7) * 256 * 4096 * 2; u.B = ws + WS_WDN + (size_t)pn * 256 * 4096 * 2; u.K = 4096; u.kind = K_DOWN; }
        else { u.A = wd + (size_t)(pmd >> 3) * GRP_STRIDE + (WS_X1B - WS_ACT) / 8 + (size_t)(pmd & 7) * 256 * 1024 * 2; u.B = ws + WS_WPG + (size_t)pn * 256 * 1024 * 2; u.K = 1024; u.kind = K_PLE; }
        u.row0 = pm * 256; u.lrow0 = pmd * 256; u.col0 = pn * 256; return true;
    }
};

__device__ __forceinline__ void st_bf16x8(bf16* p, const f32x4& a, const f32x4& b) { u32x4 w; w.x = pk2(a[0], a[1]); w.y = pk2(a[2], a[3]); w.z = pk2(b[0], b[1]); w.w = pk2(b[2], b[3]); *(u32x4*)p = w; }
__device__ __forceinline__ void st_bf16x8_wt(const Ctx& C, bf16* p, const f32x4& a, const f32x4& b) { u32x4 w; w.x = pk2(a[0], a[1]); w.y = pk2(a[2], a[3]); w.z = pk2(b[0], b[1]); w.w = pk2(b[2], b[3]);
    __builtin_amdgcn_raw_buffer_store_b128(w, __builtin_amdgcn_make_buffer_rsrc(C.wd, (short)0, 0x7fffffff, 0x00020000), (unsigned)((unsigned char*)p - C.wd), 0, 16); }
__device__ __forceinline__ void ld_bf16x8(const bf16* p, f32x4& a, f32x4& b) { const u32x4 w = *(const u32x4*)p; a = (f32x4){bflo(w.x), bfhi(w.x), bflo(w.y), bfhi(w.y)}; b = (f32x4){bflo(w.z), bfhi(w.z), bflo(w.w), bfhi(w.w)}; }
__device__ __forceinline__ float row_ss(const f32x4 (&v)[2][2]) {
    float s = 0.f;
#pragma unroll
    for (int bj = 0; bj < 2; ++bj)
#pragma unroll
        for (int n = 0; n < 2; ++n) s += (v[bj][n][0] * v[bj][n][0] + v[bj][n][1] * v[bj][n][1]) + (v[bj][n][2] * v[bj][n][2] + v[bj][n][3] * v[bj][n][3]);
    s += __shfl_xor(s, 16); s += __shfl_xor(s, 32); return s;
}
__device__ __forceinline__ float rstd_of(float ss) { return __builtin_amdgcn_rsqf(ss * (1.0f / 1024.0f) + EPS); }
template <int KIND>
__device__ __forceinline__ void epi_row(const Ctx& C, int rowu, int fr, int c64, int fq, f32x4 (&v)[2][2]) {
    const int lru = LR(rowu);
    const unsigned l512 = (unsigned)(fr * QW + 8 * fq), l128 = (unsigned)(fr * KVW + 8 * fq), l1k = (unsigned)(fr * D + 8 * fq), l4k = (unsigned)(fr * DFF + 8 * fq);
#define ST_IN(p_, a_, b_) do { if (rowu >= MP) st_bf16x8_wt(C, p_, a_, b_); else st_bf16x8(p_, a_, b_); } while (0)
    if constexpr (KIND == K_IN) {
        if (c64 < 768) {
            if (c64 < 640) {
                const float sc = __builtin_amdgcn_rsqf(row_ss(v) * (1.0f / 64.0f) + EPS) * (c64 < 512 ? 0.125f : 1.0f);
                const float* g = (c64 < 512 ? C.p0 : C.p1) + (unsigned)(8 * fq);
#pragma unroll
                for (int bj = 0; bj < 2; ++bj) { const f32x4 g0 = *(const f32x4*)(g + 32 * bj), g1 = *(const f32x4*)(g + 32 * bj + 4); v[bj][0] = v[bj][0] * g0 * sc; v[bj][1] = v[bj][1] * g1 * sc; }
            }
            if (c64 < 512) {
                bf16* ub = WSG(bf16, WS_QA, lru) + (size_t)row_loc(lru) * QW + c64;
#pragma unroll
                for (int bj = 0; bj < 2; ++bj) ST_IN(ub + l512 + 32 * bj, v[bj][0], v[bj][1]);
            } else {
                const bool isk = c64 < 640; const int ccu = c64 - (isk ? 512 : 640);
                bf16* ub = WSG(bf16, isk ? WS_K : WS_V, lru) + (size_t)row_loc(lru) * KVW + ccu;
#pragma unroll
                for (int bj = 0; bj < 2; ++bj) ST_IN(ub + l128 + 32 * bj, v[bj][0], v[bj][1]);
                if (rowu < MP) { const int b = rowu >> 11, tu = rowu & 2047;
                    if (tu >= SEQ - 128) { float* w = C.out + (isk ? O_KP : O_VP) + ((size_t)(b * 128 + tu - (SEQ - 128)) * 128 + ccu) + l128;
#pragma unroll
                        for (int bj = 0; bj < 2; ++bj) { NT_ST(v[bj][0], (f32x4*)(w + 32 * bj)); NT_ST(v[bj][1], (f32x4*)(w + 32 * bj + 4)); } } }
                else { const int bu = (rowu - MP) >> 2;
                    float* w = C.out + (isk ? O_KS : O_VS) + ((size_t)(bu * 128 + 124) * 128 + ccu) + (unsigned)((fr >> 2) * 16384 + (fr & 3) * 128 + 8 * fq);
#pragma unroll
                    for (int bj = 0; bj < 2; ++bj) { NT_ST(v[bj][0], (f32x4*)(w + 32 * bj)); NT_ST(v[bj][1], (f32x4*)(w + 32 * bj + 4)); } }
            }
        } else if (c64 < 1792) {
            const int ccu = c64 - 768;
            bf16* ub = WSG(bf16, WS_XR, lru) + (size_t)row_loc(lru) * D + ccu;
#pragma unroll
            for (int bj = 0; bj < 2; ++bj) ST_IN(ub + l1k + 32 * bj, v[bj][0], v[bj][1]);
            if (rowu < MP) { const int b = rowu >> 11, tu = rowu & 2047;
                if (tu == SEQ - 16 && fr >= 13) { float* w = C.out + O_CP + ((size_t)(b * 3 - 13) * D + ccu) + l1k;
#pragma unroll
                    for (int bj = 0; bj < 2; ++bj) { NT_ST(v[bj][0], (f32x4*)(w + 32 * bj)); NT_ST(v[bj][1], (f32x4*)(w + 32 * bj + 4)); } } }
            else { const int bu = (rowu - MP) >> 2;
                if ((fr & 3) >= 1) { float* w = C.out + O_CS + ((size_t)(bu * 3 - 1) * D + ccu) + (unsigned)((fr >> 2) * 3 * D + (fr & 3) * D + 8 * fq);
#pragma unroll
                    for (int bj = 0; bj < 2; ++bj) { NT_ST(v[bj][0], (f32x4*)(w + 32 * bj)); NT_ST(v[bj][1], (f32x4*)(w + 32 * bj + 4)); } } }
        } else {
            const bool isg = c64 < 2816; size_t off; int ccu;
            if (isg) { off = WS_GR; ccu = c64 - 1792; } else if (c64 < 3840) { off = WS_SGA; ccu = c64 - 2816; } else { off = WS_SGR; ccu = c64 - 3840; }
            bf16* ub = WSG(bf16, off, lru) + (size_t)row_loc(lru) * D + ccu;
#pragma unroll
            for (int bj = 0; bj < 2; ++bj) {
#pragma unroll
                for (int n = 0; n < 2; ++n)
#pragma unroll
                    for (int j = 0; j < 4; ++j) v[bj][n][j] = isg ? fgelu(v[bj][n][j]) : v[bj][n][j];
                ST_IN(ub + l1k + 32 * bj, v[bj][0], v[bj][1]); }
        }
#undef ST_IN
    } else if constexpr (KIND == K_ATT) {
        const bf16* ua = WSG(const bf16, WS_SGA, lru) + (size_t)row_loc(lru) * D + c64; bf16* ug = WSG(bf16, WS_G2, lru) + (size_t)row_loc(lru) * D + c64;
#pragma unroll
        for (int bj = 0; bj < 2; ++bj) { f32x4 a0, a1; ld_bf16x8(ua + l1k + 32 * bj, a0, a1); st_bf16x8(ug + l1k + 32 * bj, v[bj][0] * fsigmoid4(a0), v[bj][1] * fsigmoid4(a1)); }
    } else if constexpr (KIND == K_RNN) {
        const bf16* ur = WSG(const bf16, WS_SGR, lru) + (size_t)row_loc(lru) * D + c64; const bf16* ug = WSG(const bf16, WS_G2, lru) + (size_t)row_loc(lru) * D + c64; bf16* um = WSG(bf16, WS_MIX, lru) + (size_t)row_loc(lru) * D + c64;
#pragma unroll
        for (int bj = 0; bj < 2; ++bj) { f32x4 r0, r1, g0, g1; ld_bf16x8(ur + l1k + 32 * bj, r0, r1); ld_bf16x8(ug + l1k + 32 * bj, g0, g1); st_bf16x8(um + l1k + 32 * bj, g0 + v[bj][0] * fsigmoid4(r0), g1 + v[bj][1] * fsigmoid4(r1)); }
    } else if constexpr (KIND == K_ATTS) {
        const bf16* ua = WSG(const bf16, WS_SGA, lru) + (size_t)row_loc(lru) * D + c64; const bf16* ur = WSG(const bf16, WS_SGR, lru) + (size_t)row_loc(lru) * D + c64;
#pragma unroll
        for (int bj = 0; bj < 2; ++bj) { f32x4 a0, a1, r0, r1; ld_bf16x8(ua + l1k + 32 * bj, a0, a1); ld_bf16x8(ur + l1k + 32 * bj, r0, r1);
#pragma unroll
            for (int j = 0; j < 4; ++j) { v[bj][0][j] *= (1.f + fexp(-r0[j])) * __builtin_amdgcn_rcpf(1.f + fexp(-a0[j])); v[bj][1][j] *= (1.f + fexp(-r1[j])) * __builtin_amdgcn_rcpf(1.f + fexp(-a1[j])); } }
    } else if constexpr (KIND == K_RNNS) {
        const bf16* ur = WSG(const bf16, WS_SGR, lru) + (size_t)row_loc(lru) * D + c64; bf16* um = WSG(bf16, WS_MIX, lru) + (size_t)row_loc(lru) * D + c64;
#pragma unroll
        for (int bj = 0; bj < 2; ++bj) { f32x4 r0, r1; ld_bf16x8(ur + l1k + 32 * bj, r0, r1); st_bf16x8(um + l1k + 32 * bj, v[bj][0] * fsigmoid4(r0), v[bj][1] * fsigmoid4(r1)); }
    } else if constexpr (KIND == K_OUT || KIND == K_DOWN) {
        bf16* ub = WSG(bf16, WS_X1B, lru) + (size_t)row_loc(lru) * D + c64;
        if constexpr (KIND == K_OUT) {
            const float* src = (rowu < MP ? C.p0 + (size_t)rowu * D : C.p1 + (size_t)(rowu - MP) * D) + c64 + l1k;
#pragma unroll
            for (int bj = 0; bj < 2; ++bj) { v[bj][0] += *(const f32x4*)(src + 32 * bj); v[bj][1] += *(const f32x4*)(src + 32 * bj + 4); }
        } else {
#pragma unroll
            for (int bj = 0; bj < 2; ++bj) { f32x4 x0, x1; ld_bf16x8(ub + l1k + 32 * bj, x0, x1); v[bj][0] += x0; v[bj][1] += x1; }
        }
#pragma unroll
        for (int bj = 0; bj < 2; ++bj) st_bf16x8(ub + l1k + 32 * bj, v[bj][0], v[bj][1]);
        const float ss = row_ss(v);
        if (fq == 0) unsafeAtomicAdd(WSP(float, (KIND == K_OUT) ? WS_SS2 : WS_SS3) + rowu + fr, ss);
    } else if constexpr (KIND == K_PE) {
        bf16* ub = WSG(bf16, WS_PE, lru) + (size_t)row_loc(lru) * D + c64;
#pragma unroll
        for (int bj = 0; bj < 2; ++bj) st_bf16x8(ub + l1k + 32 * bj, v[bj][0], v[bj][1]);
    } else if constexpr (KIND == K_UP) {
        const float rs = rstd_of((WSP(const float, WS_SS2) + rowu)[fr]);
        bf16* ub = WSG(bf16, WS_HMID, lru) + (size_t)row_loc(lru) * DFF + c64;
#pragma unroll
        for (int bj = 0; bj < 2; ++bj) {
#pragma unroll
            for (int n = 0; n < 2; ++n)
#pragma unroll
                for (int j = 0; j < 4; ++j) { const float h = fmaxf(v[bj][n][j] * rs, 0.f); v[bj][n][j] = h * h; }
            st_bf16x8(ub + l4k + 32 * bj, v[bj][0], v[bj][1]); }
    } else {
        const float rs = rstd_of((WSP(const float, WS_SS3) + rowu)[fr]);
        float* dst = C.out + (size_t)rowu * D + c64 + l1k;
        const bf16* up = WSG(const bf16, WS_PE, lru) + (size_t)row_loc(lru) * D + c64; const bf16* ux = WSG(const bf16, WS_X1B, lru) + (size_t)row_loc(lru) * D + c64;
#pragma unroll
        for (int bj = 0; bj < 2; ++bj) { f32x4 p0, p1, y0, y1; ld_bf16x8(up + l1k + 32 * bj, p0, p1); ld_bf16x8(ux + l1k + 32 * bj, y0, y1);
#pragma unroll
            for (int j = 0; j < 4; ++j) { y0[j] += fsigmoid(v[bj][0][j] * rs) * p0[j]; y1[j] += fsigmoid(v[bj][1][j] * rs) * p1[j]; }
            *(f32x4*)(dst + 32 * bj) = y0; *(f32x4*)(dst + 32 * bj + 4) = y1; }
    }
}
template <int KIND>
__device__ __forceinline__ void epi_unit(const Ctx& C, f32x4 (&acc)[2][2][4][2], const Unit& u, int wr, int wc, int fr, int fq) {
    constexpr bool SW = (KIND != K_IN);
    const int c64 = u.col0 + 64 * wc + (SW ? 32 * wr : 0), sgn = (SW && wr) ? -32 : 32;
    const unsigned l1k = (unsigned)(fr * D + 8 * fq), l4k = (unsigned)(fr * DFF + 8 * fq);
#define ROWU(r) (u.row0 + ((r) >> 2) * HALF + wr * 64 + ((r) & 3) * 16)
#define LROWU(r) (u.lrow0 + ((r) >> 2) * HALF + wr * 64 + ((r) & 3) * 16)
#define ACC(r, bj, n) acc[(r) >> 2][bj][(r) & 3][n]
#define ZERO(r) do { ACC(r, 0, 0) = (f32x4){0.f, 0.f, 0.f, 0.f}; ACC(r, 0, 1) = (f32x4){0.f, 0.f, 0.f, 0.f}; ACC(r, 1, 0) = (f32x4){0.f, 0.f, 0.f, 0.f}; ACC(r, 1, 1) = (f32x4){0.f, 0.f, 0.f, 0.f}; } while (0)
    if constexpr (KIND == K_IN) {
#pragma unroll
        for (int r = 0; r < 8; ++r) { f32x4 v[2][2] = {{ACC(r, 0, 0), ACC(r, 0, 1)}, {ACC(r, 1, 0), ACC(r, 1, 1)}}; epi_row<KIND>(C, ROWU(r), fr, c64, fq, v); ZERO(r); }
    } else if constexpr (KIND == K_PE) {
#pragma unroll
        for (int r = 0; r < 8; ++r) {
#pragma unroll
            for (int bj = 0; bj < 2; ++bj) st_bf16x8(WSG(bf16, WS_PE, LROWU(r)) + (size_t)row_loc(LROWU(r)) * D + c64 + l1k + bj * sgn, ACC(r, bj, 0), ACC(r, bj, 1));
            ZERO(r); }
    } else if constexpr (KIND == K_ATT) {
        u32x4 a[8][2];
#pragma unroll
        for (int r = 0; r < 8; ++r)
#pragma unroll
            for (int bj = 0; bj < 2; ++bj) a[r][bj] = NT_LD((const u32x4*)(WSG(const bf16, WS_SGA, LROWU(r)) + (size_t)row_loc(LROWU(r)) * D + c64 + l1k + bj * sgn));
#pragma unroll
        for (int r = 0; r < 8; ++r) {
#pragma unroll
            for (int bj = 0; bj < 2; ++bj) { const u32x4 w = a[r][bj];
                st_bf16x8(WSG(bf16, WS_G2, LROWU(r)) + (size_t)row_loc(LROWU(r)) * D + c64 + l1k + bj * sgn, ACC(r, bj, 0) * fsigmoid4((f32x4){bflo(w.x), bfhi(w.x), bflo(w.y), bfhi(w.y)}), ACC(r, bj, 1) * fsigmoid4((f32x4){bflo(w.z), bfhi(w.z), bflo(w.w), bfhi(w.w)})); }
            ZERO(r); }
    } else if constexpr (KIND == K_RNN) {
#pragma unroll
        for (int b4 = 0; b4 < 8; b4 += 4) {
            u32x4 g[4][2], s[4][2];
#pragma unroll
            for (int q = 0; q < 4; ++q)
#pragma unroll
                for (int bj = 0; bj < 2; ++bj) { g[q][bj] = NT_LD((const u32x4*)(WSG(const bf16, WS_G2, LROWU(b4 + q)) + (size_t)row_loc(LROWU(b4 + q)) * D + c64 + l1k + bj * sgn)); s[q][bj] = NT_LD((const u32x4*)(WSG(const bf16, WS_SGR, LROWU(b4 + q)) + (size_t)row_loc(LROWU(b4 + q)) * D + c64 + l1k + bj * sgn)); }
#pragma unroll
            for (int q = 0; q < 4; ++q) { const int r = b4 + q;
#pragma unroll
                for (int bj = 0; bj < 2; ++bj) { const u32x4 gw = g[q][bj], sw = s[q][bj];
                    st_bf16x8(WSG(bf16, WS_MIX, LROWU(r)) + (size_t)row_loc(LROWU(r)) * D + c64 + l1k + bj * sgn,
                              (f32x4){bflo(gw.x), bfhi(gw.x), bflo(gw.y), bfhi(gw.y)} + ACC(r, bj, 0) * fsigmoid4((f32x4){bflo(sw.x), bfhi(sw.x), bflo(sw.y), bfhi(sw.y)}),
                              (f32x4){bflo(gw.z), bfhi(gw.z), bflo(gw.w), bfhi(gw.w)} + ACC(r, bj, 1) * fsigmoid4((f32x4){bflo(sw.z), bfhi(sw.z), bflo(sw.w), bfhi(sw.w)})); }
                ZERO(r); }
            asm volatile("" ::: "memory");
        }
    } else if constexpr (KIND == K_OUT) {
#pragma unroll
        for (int b4 = 0; b4 < 8; b4 += 4) {
            f32x4 x[4][2][2];
#pragma unroll
            for (int q = 0; q < 4; ++q) { const int rowu = ROWU(b4 + q); const float* src = (rowu < MP ? C.p0 + (size_t)rowu * D : C.p1 + (size_t)(rowu - MP) * D) + c64 + l1k;
#pragma unroll
                for (int bj = 0; bj < 2; ++bj) { x[q][bj][0] = NT_LD((const f32x4*)(src + bj * sgn)); x[q][bj][1] = NT_LD((const f32x4*)(src + bj * sgn + 4)); } }
#pragma unroll
            for (int q = 0; q < 4; ++q) { const int r = b4 + q; f32x4 v[2][2];
#pragma unroll
                for (int bj = 0; bj < 2; ++bj) { v[bj][0] = ACC(r, bj, 0) + x[q][bj][0]; v[bj][1] = ACC(r, bj, 1) + x[q][bj][1]; st_bf16x8(WSG(bf16, WS_X1B, LROWU(r)) + (size_t)row_loc(LROWU(r)) * D + c64 + l1k + bj * sgn, v[bj][0], v[bj][1]); }
                const float ss = row_ss(v);
                if (fq == 0) unsafeAtomicAdd(WSP(float, WS_SS2) + ROWU(r) + fr, ss);
                ZERO(r); }
            asm volatile("" ::: "memory");
        }
    } else if constexpr (KIND == K_UP) {
        float rs[8];
#pragma unroll
        for (int r = 0; r < 8; ++r) rs[r] = (WSP(const float, WS_SS2) + ROWU(r))[fr];
#pragma unroll
        for (int r = 0; r < 8; ++r) { const float k = rstd_of(rs[r]);
#pragma unroll
            for (int bj = 0; bj < 2; ++bj) { f32x4 h0 = ACC(r, bj, 0) * k, h1 = ACC(r, bj, 1) * k;
#pragma unroll
                for (int j = 0; j < 4; ++j) { const float a = fmaxf(h0[j], 0.f), b = fmaxf(h1[j], 0.f); h0[j] = a * a; h1[j] = b * b; }
                st_bf16x8(WSG(bf16, WS_HMID, LROWU(r)) + (size_t)row_loc(LROWU(r)) * DFF + c64 + l4k + bj * sgn, h0, h1); }
            ZERO(r); }
    } else if constexpr (KIND == K_DOWN) {
        u32x4 x[8][2];
#pragma unroll
        for (int r = 0; r < 8; ++r)
#pragma unroll
            for (int bj = 0; bj < 2; ++bj) x[r][bj] = *(const u32x4*)(WSG(const bf16, WS_X1B, LROWU(r)) + (size_t)row_loc(LROWU(r)) * D + c64 + l1k + bj * sgn);
#pragma unroll
        for (int r = 0; r < 8; ++r) { f32x4 v[2][2];
#pragma unroll
            for (int bj = 0; bj < 2; ++bj) { const u32x4 w = x[r][bj]; v[bj][0] = ACC(r, bj, 0) + (f32x4){bflo(w.x), bfhi(w.x), bflo(w.y), bfhi(w.y)}; v[bj][1] = ACC(r, bj, 1) + (f32x4){bflo(w.z), bfhi(w.z), bflo(w.w), bfhi(w.w)};
                st_bf16x8(WSG(bf16, WS_X1B, LROWU(r)) + (size_t)row_loc(LROWU(r)) * D + c64 + l1k + bj * sgn, v[bj][0], v[bj][1]); }
            const float ss = row_ss(v);
            if (fq == 0) unsafeAtomicAdd(WSP(float, WS_SS3) + ROWU(r) + fr, ss);
            ZERO(r); }
    } else {
#pragma unroll
        for (int b4 = 0; b4 < 8; b4 += 4) {
            u32x4 p[4][2], x[4][2]; float rs[4];
#pragma unroll
            for (int q = 0; q < 4; ++q) { rs[q] = (WSP(const float, WS_SS3) + ROWU(b4 + q))[fr];
#pragma unroll
                for (int bj = 0; bj < 2; ++bj) { p[q][bj] = NT_LD((const u32x4*)(WSG(const bf16, WS_PE, LROWU(b4 + q)) + (size_t)row_loc(LROWU(b4 + q)) * D + c64 + l1k + bj * sgn)); x[q][bj] = NT_LD((const u32x4*)(WSG(const bf16, WS_X1B, LROWU(b4 + q)) + (size_t)row_loc(LROWU(b4 + q)) * D + c64 + l1k + bj * sgn)); } }
#pragma unroll
            for (int q = 0; q < 4; ++q) { const int r = b4 + q; const float k = rstd_of(rs[q]); float* dst = C.out + (size_t)ROWU(r) * D + c64 + l1k;
#pragma unroll
                for (int bj = 0; bj < 2; ++bj) { const u32x4 pw = p[q][bj], xw = x[q][bj];
                    f32x4 y0 = (f32x4){bflo(xw.x), bfhi(xw.x), bflo(xw.y), bfhi(xw.y)}, y1 = (f32x4){bflo(xw.z), bfhi(xw.z), bflo(xw.w), bfhi(xw.w)};
                    const f32x4 p0 = (f32x4){bflo(pw.x), bfhi(pw.x), bflo(pw.y), bfhi(pw.y)}, p1 = (f32x4){bflo(pw.z), bfhi(pw.z), bflo(pw.w), bfhi(pw.w)};
#pragma unroll
                    for (int j = 0; j < 4; ++j) { y0[j] += fsigmoid(ACC(r, bj, 0)[j] * k) * p0[j]; y1[j] += fsigmoid(ACC(r, bj, 1)[j] * k) * p1[j]; }
                    NT_ST(y0, (f32x4*)(dst + bj * sgn)); NT_ST(y1, (f32x4*)(dst + bj * sgn + 4)); }
                ZERO(r); }
            asm volatile("" ::: "memory");
        }
    }
#undef ROWU
#undef LROWU
#undef ACC
#undef ZERO
}

struct XLoad { u32x4 a, b; f32x4 x0, x1; float rs; };
template <int KIND>
__device__ __forceinline__ void epi_extra_load(const Ctx& C, XLoad& xl, const Unit& u, int wr, int wc, int fr, int fq) {
    const int pmd = u.lrow0 >> 8, lsu = 8192 + 8 * pmd, gsu = MP + 256 * C.dom + 8 * pmd, cx = u.col0 + 64 * wc + 32 * wr;
    const unsigned l1k = (unsigned)(fr * D + 8 * fq);
    xl.a = (u32x4){0u, 0u, 0u, 0u}; xl.b = (u32x4){0u, 0u, 0u, 0u}; xl.x0 = (f32x4){0.f, 0.f, 0.f, 0.f}; xl.x1 = (f32x4){0.f, 0.f, 0.f, 0.f}; xl.rs = 0.f;
    if (fr < 8) {
        if constexpr (KIND == K_ATT) { xl.a = *(const u32x4*)(WSG(const bf16, WS_SGA, lsu) + (size_t)row_loc(lsu) * D + cx + l1k); xl.b = *(const u32x4*)(WSG(const bf16, WS_SGR, lsu) + (size_t)row_loc(lsu) * D + cx + l1k); }
        else if constexpr (KIND == K_RNN) { xl.b = *(const u32x4*)(WSG(const bf16, WS_SGR, lsu) + (size_t)row_loc(lsu) * D + cx + l1k); }
        else if constexpr (KIND == K_OUT) { const float* s = C.p1 + (size_t)(gsu - MP) * D + cx + l1k; xl.x0 = NT_LD((const f32x4*)s); xl.x1 = NT_LD((const f32x4*)(s + 4)); }
        else if constexpr (KIND == K_UP) { xl.rs = (WSP(const float, WS_SS2) + gsu)[fr]; }
        else if constexpr (KIND == K_DOWN) { xl.a = *(const u32x4*)(WSG(const bf16, WS_X1B, lsu) + (size_t)row_loc(lsu) * D + cx + l1k); }
        else if constexpr (KIND == K_PLE) { xl.rs = (WSP(const float, WS_SS3) + gsu)[fr]; xl.a = *(const u32x4*)(WSG(const bf16, WS_X1B, lsu) + (size_t)row_loc(lsu) * D + cx + l1k); xl.b = NT_LD((const u32x4*)(WSG(const bf16, WS_PE, lsu) + (size_t)row_loc(lsu) * D + cx + l1k)); }
    }
}
#define UNPK_LO(q_) ((f32x4){bflo((q_).x), bfhi((q_).x), bflo((q_).y), bfhi((q_).y)})
#define UNPK_HI(q_) ((f32x4){bflo((q_).z), bfhi((q_).z), bflo((q_).w), bfhi((q_).w)})
template <int KIND>
__device__ __forceinline__ void epi_extra(const Ctx& C, f32x4 (&ax)[2], const XLoad& xl, const Unit& u, int wr, int wc, int fr, int fq) {
    const int pmd = u.lrow0 >> 8, lsu = 8192 + 8 * pmd, gsu = MP + 256 * C.dom + 8 * pmd, cx = u.col0 + 64 * wc + 32 * wr;
    const unsigned l1k = (unsigned)(fr * D + 8 * fq), l4k = (unsigned)(fr * DFF + 8 * fq);
    const bool ok = fr < 8;
    if constexpr (KIND == K_ATT) {
        const f32x4 a0 = UNPK_LO(xl.a), a1 = UNPK_HI(xl.a), r0 = UNPK_LO(xl.b), r1 = UNPK_HI(xl.b);
#pragma unroll
        for (int j = 0; j < 4; ++j) { ax[0][j] *= (1.f + fexp(-r0[j])) * __builtin_amdgcn_rcpf(1.f + fexp(-a0[j])); ax[1][j] *= (1.f + fexp(-r1[j])) * __builtin_amdgcn_rcpf(1.f + fexp(-a1[j])); }
        return;
    } else if constexpr (KIND == K_RNN) {
        if (ok) st_bf16x8(WSG(bf16, WS_MIX, lsu) + (size_t)row_loc(lsu) * D + cx + l1k, ax[0] * fsigmoid4(UNPK_LO(xl.b)), ax[1] * fsigmoid4(UNPK_HI(xl.b)));
    } else if constexpr (KIND == K_OUT || KIND == K_DOWN) {
        f32x4 v0, v1;
        if constexpr (KIND == K_OUT) { v0 = ax[0] + xl.x0; v1 = ax[1] + xl.x1; } else { v0 = ax[0] + UNPK_LO(xl.a); v1 = ax[1] + UNPK_HI(xl.a); }
        if (ok) st_bf16x8(WSG(bf16, WS_X1B, lsu) + (size_t)row_loc(lsu) * D + cx + l1k, v0, v1);
        float ss = (v0[0] * v0[0] + v0[1] * v0[1]) + (v0[2] * v0[2] + v0[3] * v0[3]) + (v1[0] * v1[0] + v1[1] * v1[1]) + (v1[2] * v1[2] + v1[3] * v1[3]);
        ss += __shfl_xor(ss, 16); ss += __shfl_xor(ss, 32);
        if (ok && fq == 0) unsafeAtomicAdd(WSP(float, (KIND == K_OUT) ? WS_SS2 : WS_SS3) + gsu + fr, ss);
    } else if constexpr (KIND == K_PE) {
        if (ok) st_bf16x8(WSG(bf16, WS_PE, lsu) + (size_t)row_loc(lsu) * D + cx + l1k, ax[0], ax[1]);
    } else if constexpr (KIND == K_UP) {
        const float k = rstd_of(xl.rs); f32x4 h0 = ax[0] * k, h1 = ax[1] * k;
#pragma unroll
        for (int j = 0; j < 4; ++j) { const float a = fmaxf(h0[j], 0.f), b = fmaxf(h1[j], 0.f); h0[j] = a * a; h1[j] = b * b; }
        if (ok) st_bf16x8(WSG(bf16, WS_HMID, lsu) + (size_t)row_loc(lsu) * DFF + cx + l4k, h0, h1);
    } else {
        const float k = rstd_of(xl.rs); f32x4 y0 = UNPK_LO(xl.a), y1 = UNPK_HI(xl.a); const f32x4 p0 = UNPK_LO(xl.b), p1 = UNPK_HI(xl.b);
#pragma unroll
        for (int j = 0; j < 4; ++j) { y0[j] += fsigmoid(ax[0][j] * k) * p0[j]; y1[j] += fsigmoid(ax[1][j] * k) * p1[j]; }
        if (ok) { float* dst = C.out + (size_t)gsu * D + cx + l1k; NT_ST(y0, (f32x4*)dst); NT_ST(y1, (f32x4*)(dst + 4)); }
    }
    ax[0] = (f32x4){0.f, 0.f, 0.f, 0.f}; ax[1] = (f32x4){0.f, 0.f, 0.f, 0.f};
}
#undef UNPK_LO
#undef UNPK_HI

template <int PH>
__device__ __forceinline__ int gemm_phase(LAS unsigned char* lds, const Ctx& C, int wid) {
    const int lane = lane_fresh(), tid = wid * 64 + lane, wr = wid >> 2, wc = wid & 3, fr = lane & 15, fq = lane >> 4;
    Sched<PH> S; S.G = C.G; S.c = C.c; S.dom = C.dom; S.ws = (const char*)C.ws; S.wd = (const char*)C.wd;
#define STAGE_IDS() int sRa[2], sRb[2], sC[2], xRC; { const int sl = lane_fresh(), stid = wid * 64 + sl; \
        _Pragma("unroll") for (int i = 0; i < 2; ++i) { int R, Cc; stage_rc(stid * 16 + i * 8192, R, Cc); sRa[i] = R; sRb[i] = 64 * (R >> 5) + perm32(R & 31); sC[i] = Cc; } \
        const int L = wid * 256 + sl * 4, st = L >> 10, sb = L & 1023, ob = sb ^ (((sb >> 9) & 1) << 5); xRC = (((ob >> 6) & 7) << 8) | (st * 32 + (ob & 63) / 2); }
    const size_t kstep = (size_t)(BK * 2);
    const unsigned ldsw = (unsigned)wid * 1024u;
    const int aoff = lds_byte(wr * 64 + fr, fq * 8), boff = lds_byte(wc * 32 + fr, fq * 8), xoffr = lds_byte(fr, fq * 8);
    constexpr bool XT = (PH != PH_IN);
    constexpr int XA_OFF = 131072 + 4096;
    const int boff0 = boff + (XT ? wr * HTB : 0), boff1 = boff + (XT ? (wr ^ 1) * HTB : HTB);
    const unsigned xldsw = (unsigned)wid * 256u;
#define PG8_XSTAGE(b, gbase, v) do { if constexpr (XT) __builtin_amdgcn_global_load_lds((const unsigned*)((const char*)(gbase) + (v)), (LAS unsigned*)(lds + XA_OFF + (b) * 2048 + xldsw), 4, 0, 0); } while (0)
#define PG8_LDX(b) do { if constexpr (XT) { Xt[0] = *(const LAS bf16x8*)(lds + XA_OFF + (b) * 2048 + xoffr); Xt[1] = *(const LAS bf16x8*)(lds + XA_OFF + (b) * 2048 + xoffr + 1024); } } while (0)
#define PG8_XMMA() do { if constexpr (XT) { \
        _Pragma("unroll") for (int n = 0; n < 2; ++n) _Pragma("unroll") for (int k = 0; k < 2; ++k) accx[n] = __builtin_amdgcn_mfma_f32_16x16x32_bf16(B0[n][k], Xt[k], accx[n], 0, 0, 0); \
        } } while (0)
#define XVOFF(u) ((unsigned)((xRC >> 8) * (u).K + (xRC & 255)) * 2u + (unsigned)((2048 - 248 * (((u).lrow0 >> 8) & 7)) * (u).K * 2))
#define PG8_SA(b, h) (((b) * 2 + (h)) * HTB)
#define PG8_SB(b, h) ((4 + (b) * 2 + (h)) * HTB)
#define PG8_STAGE(bufoff, gbase, v0, d1) do {   \
        __builtin_amdgcn_global_load_lds((const unsigned*)((const char*)(gbase) + (v0)), (LAS unsigned*)(lds + (bufoff) + ldsw), 16, 0, 0); \
        __builtin_amdgcn_global_load_lds((const unsigned*)((const char*)(gbase) + (d1) + (v0)), (LAS unsigned*)(lds + (bufoff) + ldsw + 8192), 16, 0, 0); } while (0)
#define PG8_LDA(dst, b, h) do { _Pragma("unroll") for (int m = 0; m < 4; ++m) _Pragma("unroll") for (int k = 0; k < 2; ++k) dst[m][k] = *(const LAS bf16x8*)(lds + PG8_SA(b, h) + aoff + m * 2048 + k * 1024); } while (0)
#define PG8_LDB(dst, b, h) do { _Pragma("unroll") for (int n = 0; n < 2; ++n) _Pragma("unroll") for (int k = 0; k < 2; ++k) dst[n][k] = *(const LAS bf16x8*)(lds + PG8_SB(b, 0) + ((h) ? boff1 : boff0) + n * 2048 + k * 1024); } while (0)
#define PG8_MMA(ai, bj, At, Bt) do { _Pragma("unroll") for (int m = 0; m < 4; ++m) _Pragma("unroll") for (int n = 0; n < 2; ++n) _Pragma("unroll") for (int k = 0; k < 2; ++k) \
        acc[ai][bj][m][n] = __builtin_amdgcn_mfma_f32_16x16x32_bf16(Bt[n][k], At[m][k], acc[ai][bj][m][n], 0, 0, 0); } while (0)
#define PG8_PRIO(p) __builtin_amdgcn_s_setprio(p)
#define PG8_WAIT_V(n) asm volatile("s_waitcnt vmcnt(" #n ")" ::: "memory")
#define PG8_WAIT_LOOP() do { if constexpr (XT) PG8_WAIT_V(9); else PG8_WAIT_V(8); } while (0)
#define PG8_WAIT_L(n) asm volatile("s_waitcnt lgkmcnt(" #n ")" ::: "memory")
#define PG8_BAR __builtin_amdgcn_s_barrier()
#define PG8_SCHED __builtin_amdgcn_sched_barrier(0)
    Unit cur, nxt; int ui = 0, nsamp = 0;
    if (!S.next(0, cur)) return 0;
    f32x4 acc[2][2][4][2];
#pragma unroll
    for (int a = 0; a < 2; ++a)
#pragma unroll
        for (int b = 0; b < 2; ++b)
#pragma unroll
            for (int m = 0; m < 4; ++m)
#pragma unroll
                for (int n = 0; n < 2; ++n) acc[a][b][m][n] = (f32x4){0.f, 0.f, 0.f, 0.f};
    bf16x8 At[4][2], B0[2][2], B1[2][2], Xt[2];
    f32x4 accx[2] = {(f32x4){0.f, 0.f, 0.f, 0.f}, (f32x4){0.f, 0.f, 0.f, 0.f}};
    const char* cA = cur.A; const char* cB = cur.B; unsigned vX, vA0, vB0;
    { STAGE_IDS(); vX = XVOFF(cur); vA0 = (unsigned)(sRa[0] * cur.K + sC[0]) * 2u; vB0 = (unsigned)(sRb[0] * cur.K + sC[0]) * 2u; }
    unsigned hA = (PH == PH_IN && cur.lrow0 == 8192) ? (unsigned)(2 * GRP_STRIDE) : (unsigned)(HALF * cur.K * 2), hB = (unsigned)(32 * cur.K * 2);
    PG8_XSTAGE(0, cA, vX);
    PG8_STAGE(PG8_SB(0, 0), cB, vB0, hB * 4u); PG8_STAGE(PG8_SB(0, 1), cB + hB, vB0, hB * 4u); PG8_STAGE(PG8_SA(0, 0), cA, vA0, hA >> 1); PG8_STAGE(PG8_SA(0, 1), cA + hA, vA0, hA >> 1);
    if (wr == 1) PG8_BAR;
    PG8_WAIT_V(2); PG8_BAR;
    PG8_STAGE(PG8_SB(1, 0), cB + kstep, vB0, hB * 4u); PG8_STAGE(PG8_SA(1, 0), cA + kstep, vA0, hA >> 1); PG8_STAGE(PG8_SB(1, 1), cB + hB + kstep, vB0, hB * 4u);
    PG8_WAIT_V(6); PG8_BAR;
    for (;;) {
        const bool has_next = S.next(ui + 1, nxt);
        const char* nA = has_next ? nxt.A : cA; const char* nB = has_next ? nxt.B : cB; const int nK = has_next ? nxt.K : cur.K;
        unsigned nvX, nvA0, nvB0;
        { STAGE_IDS(); nvX = has_next ? XVOFF(nxt) : vX; nvA0 = (unsigned)(sRa[0] * nK + sC[0]) * 2u; nvB0 = (unsigned)(sRb[0] * nK + sC[0]) * 2u; }
        const unsigned nhA = (PH == PH_IN && has_next && nxt.lrow0 == 8192) ? (unsigned)(2 * GRP_STRIDE) : (unsigned)(HALF * nK * 2), nhB = (unsigned)(32 * nK * 2);
        const int nt = cur.K / BK;
        for (int t = 0; t < nt; t += 2) {
            const bool last = (t == nt - 2);
            const char* a1 = cA + (size_t)(t + 1) * kstep;
            const char* a2 = last ? nA : cA + (size_t)(t + 2) * kstep; const char* b2 = last ? nB : cB + (size_t)(t + 2) * kstep;
            const char* a3 = a2 + kstep; const char* b3 = b2 + kstep;
            const unsigned xA0 = last ? nvA0 : vA0, xB0 = last ? nvB0 : vB0;
            const unsigned xhA = last ? nhA : hA, xhB = last ? nhB : hB;
            const unsigned xvX = last ? nvX : vX;
            PG8_LDB(B0, 0, 0); PG8_LDB(B1, 0, 1); PG8_SCHED; PG8_LDA(At, 0, 0); PG8_STAGE(PG8_SA(1, 1), a1 + hA, vA0, hA >> 1); PG8_XSTAGE(1, a1, vX);
            PG8_PRIO(1); PG8_WAIT_LOOP(); PG8_WAIT_L(0); PG8_BAR; PG8_MMA(0, 0, At, B0); PG8_MMA(0, 1, At, B1); PG8_PRIO(0); PG8_BAR; PG8_SCHED;
            PG8_LDA(At, 0, 1); PG8_LDX(0); PG8_STAGE(PG8_SB(0, 0), b2, xB0, xhB * 4u); PG8_STAGE(PG8_SB(0, 1), b2 + xhB, xB0, xhB * 4u); PG8_STAGE(PG8_SA(0, 0), a2, xA0, xhA >> 1);
            PG8_PRIO(1); PG8_WAIT_LOOP(); PG8_WAIT_L(0); PG8_BAR; PG8_MMA(1, 0, At, B0); PG8_MMA(1, 1, At, B1); PG8_XMMA(); PG8_PRIO(0); PG8_BAR; PG8_SCHED;
            PG8_LDB(B0, 1, 0); PG8_LDB(B1, 1, 1); PG8_SCHED; PG8_LDA(At, 1, 0); PG8_STAGE(PG8_SA(0, 1), a2 + xhA, xA0, xhA >> 1); PG8_XSTAGE(0, a2, xvX);
            PG8_PRIO(1); PG8_WAIT_LOOP(); PG8_WAIT_L(0); PG8_BAR; PG8_MMA(0, 0, At, B0); PG8_MMA(0, 1, At, B1); PG8_PRIO(0); PG8_BAR; PG8_SCHED;
            PG8_LDA(At, 1, 1); PG8_LDX(1); PG8_STAGE(PG8_SB(1, 0), b3, xB0, xhB * 4u); PG8_STAGE(PG8_SB(1, 1), b3 + xhB, xB0, xhB * 4u); PG8_STAGE(PG8_SA(1, 0), a3, xA0, xhA >> 1);
            PG8_PRIO(1); PG8_WAIT_LOOP(); PG8_WAIT_L(0); PG8_BAR; PG8_MMA(1, 0, At, B0); PG8_MMA(1, 1, At, B1); PG8_XMMA(); PG8_PRIO(0); PG8_BAR; PG8_SCHED;
        }
        if (wr == 0) PG8_BAR;
        const int el = lane_fresh(), efr = el & 15, efq = el >> 4;
#define EPI(KIND) do { XLoad xl; epi_extra_load<KIND>(C, xl, cur, wr, wc, efr, efq); epi_unit<KIND>(C, acc, cur, wr, wc, efr, efq); epi_extra<KIND>(C, accx, xl, cur, wr, wc, efr, efq); } while (0)
        if constexpr (PH == PH_IN) epi_unit<K_IN>(C, acc, cur, wr, wc, efr, efq);
        else if constexpr (PH == PH_MIX) { if (cur.kind == K_ATT) EPI(K_ATT); else EPI(K_RNN); }
        else if constexpr (PH == PH_OUT) { if (cur.kind == K_OUT) EPI(K_OUT); else EPI(K_PE); }
        else if constexpr (PH == PH_UP) EPI(K_UP);
        else if constexpr (PH == PH_DOWN) EPI(K_DOWN);
        else EPI(K_PLE);
#undef EPI
        if constexpr (PH == PH_IN) nsamp += (cur.lrow0 == 8192) ? 1 : 0;
        if (!has_next) break;
        cur = nxt; cA = nA; cB = nB; vX = nvX; ++ui; vA0 = nvA0; vB0 = nvB0; hA = nhA; hB = nhB;
        if (wr == 1) PG8_BAR;
    }
    PG8_WAIT_V(0);
    PG8_BAR;
    return nsamp;
#undef STAGE_IDS
#undef PG8_XSTAGE
#undef PG8_LDX
#undef PG8_XMMA
#undef XVOFF
#undef PG8_WAIT_LOOP
#undef PG8_SA
#undef PG8_SB
#undef PG8_STAGE
#undef PG8_LDA
#undef PG8_LDB
#undef PG8_MMA
#undef PG8_PRIO
#undef PG8_WAIT_V
#undef PG8_WAIT_L
#undef PG8_BAR
#undef PG8_SCHED
}

__device__ __forceinline__ void p0_transpose_item(const float* W, int K, int N, bf16* WT, const float* gain, LAS float* scr, int item, int lane) {
    const int nblk = N / 32, kb = item / nblk, nb = item % nblk, k0 = 64 * kb, n0 = 32 * nb;
    const int kl = lane >> 3, n4 = (lane & 7) * 4;
    f32x4 w[8]; float g[8];
#pragma unroll
    for (int i = 0; i < 8; ++i) { w[i] = NT_LD((const f32x4*)(W + (size_t)(k0 + kl + 8 * i) * N + n0 + n4)); g[i] = gain ? gain[k0 + kl + 8 * i] : 1.f; }
#pragma unroll
    for (int i = 0; i < 8; ++i) { LAS float* s = scr + (kl + 8 * i) * 33 + n4; s[0] = w[i][0] * g[i]; s[1] = w[i][1] * g[i]; s[2] = w[i][2] * g[i]; s[3] = w[i][3] * g[i]; }
    LDS_WAIT(); asm volatile("" ::: "memory");
    const int c = lane & 7;
#pragma unroll
    for (int j = 0; j < 4; ++j) { const int n = (lane >> 3) + 8 * j; const LAS float* s = scr + (8 * c) * 33 + n;
        u32x4 o; o.x = pk2(s[0 * 33], s[1 * 33]); o.y = pk2(s[2 * 33], s[3 * 33]); o.z = pk2(s[4 * 33], s[5 * 33]); o.w = pk2(s[6 * 33], s[7 * 33]);
        __builtin_amdgcn_raw_buffer_store_b128(o, __builtin_amdgcn_make_buffer_rsrc(WT, (short)0, 0x7fffffff, 0x00020000), (unsigned)(((n0 + n) * K + k0 + 8 * c) * 2), 0, 16); }
    LDS_WAIT(); asm volatile("" ::: "memory");
}
__device__ __forceinline__ void p0a_prologue(const Ctx& C, LAS unsigned char* lds, int gi, int ng, int tid, int wave, int lane) {
    LAS float* scr = (LAS float*)(lds + wave * 16384);
    const int gw = gi * 8 + wave, NGW = ng * 8;
    {
        const float* xp = karg<I_XP>(); const float* xs = karg<I_XS>(); const float* pp = karg<I_PP>(); const float* ps = karg<I_PS>();
#pragma unroll 1
        for (int m0 = 2 * gw; m0 < M; m0 += 2 * NGW) {
            f32x4 v[2][4], pv[2];
#pragma unroll
            for (int r = 0; r < 2; ++r) { const int m = m0 + r;
                const f32x4* xr = (const f32x4*)(m < MP ? xp + (size_t)m * D : xs + (size_t)(m - MP) * D) + lane;
#pragma unroll
                for (int j = 0; j < 4; ++j) v[r][j] = NT_LD(xr + 64 * j);
                pv[r] = NT_LD((const f32x4*)(m < MP ? pp + (size_t)m * PLE : ps + (size_t)(m - MP) * PLE) + lane); }
#pragma unroll
            for (int r = 0; r < 2; ++r) { const int m = m0 + r; float s = 0.f;
#pragma unroll
                for (int j = 0; j < 4; ++j) s += (v[r][j][0] * v[r][j][0] + v[r][j][1] * v[r][j][1]) + (v[r][j][2] * v[r][j][2] + v[r][j][3] * v[r][j][3]);
                const float rstd = __builtin_amdgcn_rsqf(wave_sum(s) * (1.f / D) + EPS);
                const int rd = m < MP ? (m >> 13) : ((m - MP) >> 8), rj = m < MP ? (m & 8191) : 8192 + ((m - MP) & 255);
            u32x2* o8 = (u32x2*)((bf16*)(C.ws + WS_ACT + (size_t)rd * DOM_STRIDE + (size_t)row_grp(rj) * GRP_STRIDE + (WS_XN - WS_ACT) / 8) + (size_t)row_loc(rj) * D) + lane;
#pragma unroll
                for (int j = 0; j < 4; ++j) { u32x2 w; w.x = pk2(v[r][j][0] * rstd, v[r][j][1] * rstd); w.y = pk2(v[r][j][2] * rstd, v[r][j][3] * rstd); __builtin_amdgcn_raw_buffer_store_b64(w, __builtin_amdgcn_make_buffer_rsrc(C.ws, (short)0, 0x7fffffff, 0x00020000), (unsigned)((unsigned char*)(o8 + 64 * j) - C.ws), 0, 16); }
                u32x2 w; w.x = pk2(pv[r][0], pv[r][1]); w.y = pk2(pv[r][2], pv[r][3]);
                __builtin_amdgcn_raw_buffer_store_b64(w, __builtin_amdgcn_make_buffer_rsrc(C.ws, (short)0, 0x7fffffff, 0x00020000), (unsigned)((unsigned char*)((u32x2*)((bf16*)(C.ws + WS_ACT + (size_t)rd * DOM_STRIDE + (size_t)row_grp(rj) * GRP_STRIDE + (WS_PB - WS_ACT) / 8) + (size_t)row_loc(rj) * PLE) + lane) - C.ws), 0, 16); }
        }
    }
    for (int i = gi * 512 + tid; i < M; i += ng * 512) { __hip_atomic_store(WSP(float, WS_SS2) + i, 0.f, __ATOMIC_RELAXED, __HIP_MEMORY_SCOPE_AGENT); __hip_atomic_store(WSP(float, WS_SS3) + i, 0.f, __ATOMIC_RELAXED, __HIP_MEMORY_SCOPE_AGENT); }
    constexpr int I_IN = 16 * (NIN / 32), I_RG = 2 * 16;
#pragma unroll 1
    for (int it = gw; it < I_IN + 2 * I_RG; it += NGW) {
        int r = it;
        if (r < I_IN) { p0_transpose_item(karg<I_WIN>(), D, NIN, WSP(bf16, WS_WIN), karg<I_N1G>(), scr, r, lane); continue; } r -= I_IN;
        if (r < I_RG) { p0_transpose_item(karg<I_RGWA>() + (size_t)(r >> 1) * 4096, 64, 64, WSP(bf16, WS_WRGA) + (size_t)(r >> 1) * 4096, nullptr, scr, r & 1, lane); continue; } r -= I_RG;
        p0_transpose_item(karg<I_RGWX>() + (size_t)(r >> 1) * 4096, 64, 64, WSP(bf16, WS_WRGX) + (size_t)(r >> 1) * 4096, nullptr, scr, r & 1, lane);
    }
}
__device__ __forceinline__ void cache_shift(const Ctx& C, int gi, int ng, int tid) {
    {
        const float* ck = karg<I_CK>(); const float* cv = karg<I_CV>();
        const int gt = gi * 512 + tid, NGT = ng * 512;
        constexpr int NQ = 2 * 128 * 3968;
#pragma unroll 1
        for (int idx0 = gt; idx0 < NQ; idx0 += 4 * NGT) {
            f32x4 t[4];
#pragma unroll
            for (int u = 0; u < 4; ++u) { const int idx = idx0 + u * NGT; if (idx < NQ) { const int arr = idx >= 128 * 3968, r = idx - arr * 128 * 3968, b = r / 3968, e4 = r % 3968;
                t[u] = NT_LD((const f32x4*)(arr ? cv : ck) + (size_t)b * 4096 + 128 + e4); } }
#pragma unroll
            for (int u = 0; u < 4; ++u) { const int idx = idx0 + u * NGT; if (idx < NQ) { const int arr = idx >= 128 * 3968, r = idx - arr * 128 * 3968, b = r / 3968, e4 = r % 3968;
                NT_ST(t[u], (f32x4*)(C.out + (arr ? O_VS : O_KS)) + (size_t)b * 4096 + e4); } }
        }
    }
}
struct P0Item { const float* W; bf16* WT; const float* gain; int K, N, r; };
__device__ __forceinline__ void p0_item_load(const P0Item& d, int lane, f32x4 (&w)[8], float (&g)[8]) {
    const int nblk = d.N / 32, kb = d.r / nblk, nb = d.r % nblk, k0 = 64 * kb, n0 = 32 * nb, kl = lane >> 3, n4 = (lane & 7) * 4;
#pragma unroll
    for (int i = 0; i < 8; ++i) { w[i] = NT_LD((const f32x4*)(d.W + (size_t)(k0 + kl + 8 * i) * d.N + n0 + n4)); g[i] = d.gain ? d.gain[k0 + kl + 8 * i] : 1.f; }
}
__device__ __forceinline__ void p0_item_finish(const P0Item& d, int lane, LAS float* scr, const f32x4 (&w)[8], const float (&g)[8]) {
    const int nblk = d.N / 32, kb = d.r / nblk, nb = d.r % nblk, k0 = 64 * kb, n0 = 32 * nb, kl = lane >> 3, n4 = (lane & 7) * 4;
#pragma unroll
    for (int i = 0; i < 8; ++i) { LAS float* s = scr + (kl + 8 * i) * 33 + n4; s[0] = w[i][0] * g[i]; s[1] = w[i][1] * g[i]; s[2] = w[i][2] * g[i]; s[3] = w[i][3] * g[i]; }
    LDS_WAIT(); asm volatile("" ::: "memory");
    const int c = lane & 7;
#pragma unroll
    for (int j = 0; j < 4; ++j) { const int n = (lane >> 3) + 8 * j; const LAS float* s = scr + (8 * c) * 33 + n;
        u32x4 o; o.x = pk2(s[0 * 33], s[1 * 33]); o.y = pk2(s[2 * 33], s[3 * 33]); o.z = pk2(s[4 * 33], s[5 * 33]); o.w = pk2(s[6 * 33], s[7 * 33]);
        __builtin_amdgcn_raw_buffer_store_b128(o, __builtin_amdgcn_make_buffer_rsrc(d.WT, (short)0, 0x7fffffff, 0x00020000), (unsigned)(((n0 + n) * d.K + k0 + 8 * c) * 2), 0, 16); }
    LDS_WAIT(); asm volatile("" ::: "memory");
}
__device__ __forceinline__ void p0b_prologue(const Ctx& C, LAS unsigned char* lds, int gi, int ng, int it_begin, int it_end, int tid, int wave, int lane) {
    LAS float* scr = (LAS float*)(lds + wave * 16384);
    const int gw = gi * 8 + wave, NGW = ng * 8;
    constexpr int I_OA = 8 * 32, I_SQ = 16 * 32, I_UP = 16 * 128, I_DN = 64 * 32, I_PLE = 4 * 32;
    constexpr int NITEMS = I_OA + 3 * I_SQ + I_UP + I_DN + I_PLE;
#define P0B_DESC(d, it_) do { int r = (it_); \
        if (r < I_OA) { d.W = karg<I_WOA>(); d.K = QW; d.N = D; d.WT = WSP(bf16, WS_WOA); d.gain = nullptr; } else { r -= I_OA; \
        if (r < I_SQ) { d.W = karg<I_WOR>(); d.K = D; d.N = D; d.WT = WSP(bf16, WS_WOR); d.gain = nullptr; } else { r -= I_SQ; \
        if (r < I_SQ) { d.W = karg<I_WOUT>(); d.K = D; d.N = D; d.WT = WSP(bf16, WS_WOUT); d.gain = nullptr; } else { r -= I_SQ; \
        if (r < I_SQ) { d.W = karg<I_WPG>(); d.K = D; d.N = D; d.WT = WSP(bf16, WS_WPG); d.gain = karg<I_PNG>(); } else { r -= I_SQ; \
        if (r < I_UP) { d.W = karg<I_WUP>(); d.K = D; d.N = DFF; d.WT = WSP(bf16, WS_WUP); d.gain = karg<I_N2G>(); } else { r -= I_UP; \
        if (r < I_DN) { d.W = karg<I_WDN>(); d.K = DFF; d.N = D; d.WT = WSP(bf16, WS_WDN); d.gain = nullptr; } else { r -= I_DN; \
        d.W = karg<I_WPLE>(); d.K = PLE; d.N = D; d.WT = WSP(bf16, WS_WPLE); d.gain = nullptr; } } } } } } d.r = r; } while (0)
    if (it_end > NITEMS) it_end = NITEMS;
#pragma unroll 1
    for (int it = it_begin + gw; it < it_end; it += 2 * NGW) {
        P0Item d0, d1; f32x4 w0[8], w1[8]; float g0[8], g1[8];
        const bool two = it + NGW < it_end;
        P0B_DESC(d0, it); p0_item_load(d0, lane, w0, g0);
        if (two) { P0B_DESC(d1, it + NGW); p0_item_load(d1, lane, w1, g1); }
        p0_item_finish(d0, lane, scr, w0, g0);
        if (two) p0_item_finish(d1, lane, scr, w1, g1);
    }
#undef P0B_DESC
}

__device__ __forceinline__ int rel_bucket(int n) {
    if (n < 16) return n;
    const float v = __logf((float)n * (1.0f / 16.0f)) / 2.0794415416798357f * 16.0f;
    const int l = 16 + (int)v; return l < 31 ? l : 31;
}
template <int NDT, int U, bool WAIT>
__device__ __forceinline__ void v_read(unsigned vb, s16x4 (&lo)[NDT], s16x4 (&hi)[NDT]) {
    constexpr int T0 = 2 * U, T1 = (2 * U + 1 < 9) ? 2 * U + 1 : 2 * U;
    if constexpr (NDT == 4) {
        if constexpr (WAIT)
        asm volatile("ds_read_b64_tr_b16 %0, %8 offset:%9\n\tds_read_b64_tr_b16 %1, %8 offset:%10\n\tds_read_b64_tr_b16 %2, %8 offset:%11\n\tds_read_b64_tr_b16 %3, %8 offset:%12\n\t"
                     "ds_read_b64_tr_b16 %4, %8 offset:%13\n\tds_read_b64_tr_b16 %5, %8 offset:%14\n\tds_read_b64_tr_b16 %6, %8 offset:%15\n\tds_read_b64_tr_b16 %7, %8 offset:%16\n\ts_waitcnt lgkmcnt(0)"
                     : "=&v"(lo[0]), "=&v"(lo[1]), "=&v"(lo[2]), "=&v"(lo[3]), "=&v"(hi[0]), "=&v"(hi[1]), "=&v"(hi[2]), "=&v"(hi[3])
                     : "v"(vb), "n"(T0 * 2304), "n"(T0 * 2304 + 32), "n"(T0 * 2304 + 64), "n"(T0 * 2304 + 96), "n"(T1 * 2304), "n"(T1 * 2304 + 32), "n"(T1 * 2304 + 64), "n"(T1 * 2304 + 96) : "memory");
        else
        asm volatile("ds_read_b64_tr_b16 %0, %8 offset:%9\n\tds_read_b64_tr_b16 %1, %8 offset:%10\n\tds_read_b64_tr_b16 %2, %8 offset:%11\n\tds_read_b64_tr_b16 %3, %8 offset:%12\n\t"
                     "ds_read_b64_tr_b16 %4, %8 offset:%13\n\tds_read_b64_tr_b16 %5, %8 offset:%14\n\tds_read_b64_tr_b16 %6, %8 offset:%15\n\tds_read_b64_tr_b16 %7, %8 offset:%16"
                     : "=&v"(lo[0]), "=&v"(lo[1]), "=&v"(lo[2]), "=&v"(lo[3]), "=&v"(hi[0]), "=&v"(hi[1]), "=&v"(hi[2]), "=&v"(hi[3])
                     : "v"(vb), "n"(T0 * 2304), "n"(T0 * 2304 + 32), "n"(T0 * 2304 + 64), "n"(T0 * 2304 + 96), "n"(T1 * 2304), "n"(T1 * 2304 + 32), "n"(T1 * 2304 + 64), "n"(T1 * 2304 + 96) : "memory");
    } else {
        if constexpr (WAIT)
        asm volatile("ds_read_b64_tr_b16 %0, %2 offset:%3\n\tds_read_b64_tr_b16 %1, %2 offset:%4\n\ts_waitcnt lgkmcnt(0)"
                     : "=&v"(lo[0]), "=&v"(hi[0]) : "v"(vb), "n"(T0 * 2304), "n"(T1 * 2304) : "memory");
        else
        asm volatile("ds_read_b64_tr_b16 %0, %2 offset:%3\n\tds_read_b64_tr_b16 %1, %2 offset:%4"
                     : "=&v"(lo[0]), "=&v"(hi[0]) : "v"(vb), "n"(T0 * 2304), "n"(T1 * 2304) : "memory");
    }
}
template <int NDT, int U>
__device__ __forceinline__ void pv_mma(const f32x4 (&s)[9], const s16x4 (&lo)[NDT], const s16x4 (&hi)[NDT], f32x4 (&o)[NDT]) {
    constexpr int T0 = 2 * U, T1 = (2 * U + 1 < 9) ? 2 * U + 1 : 2 * U;
    u32x4 pw; pw.x = pk2(s[T0][0], s[T0][1]); pw.y = pk2(s[T0][2], s[T0][3]);
    if constexpr (2 * U + 1 < 9) { pw.z = pk2(s[T1][0], s[T1][1]); pw.w = pk2(s[T1][2], s[T1][3]); } else { pw.z = 0u; pw.w = 0u; }
    const bf16x8 pf = __builtin_bit_cast(bf16x8, pw);
#pragma unroll
    for (int d = 0; d < NDT; ++d) { const bf16x8 vf = __builtin_shufflevector(lo[d], hi[d], 0, 1, 2, 3, 4, 5, 6, 7); o[d] = MFMA16(vf, pf, o[d]); }
}
template <int NDT>
__device__ __forceinline__ void attn_core(const bf16x8 q0, const bf16x8 q1, const LAS unsigned char* Kl, unsigned vbase, int kt0, int qkey, int tmin, float sinkv, const LAS float* brow, int dt0, int fr, int fq, f32x4 (&o)[NDT]) {
    f32x4 s[9];
    const LAS unsigned char* kp = Kl + (16 * kt0 + fr) * 144 + fq * 16;
#pragma unroll
    for (int t = 0; t < 9; ++t) {
        const bf16x8 k0 = *(const LAS bf16x8*)(kp + t * 2304), k1 = *(const LAS bf16x8*)(kp + t * 2304 + 64);
        f32x4 a = (f32x4){0.f, 0.f, 0.f, 0.f};
        a = MFMA16(k0, q0, a); a = MFMA16(k1, q1, a);
        s[t] = a;
    }
    float mx = sinkv;
    const LAS float* bp = brow + (qkey - 16 * kt0 - 4 * fq + 16 - 3 - 128);
#pragma unroll
    for (int t = 0; t < 9; ++t) {
        const float tp = (kt0 + t < tmin) ? -1e30f : 0.f;
#pragma unroll
        for (int jj = 0; jj < 4; ++jj) { const float v = s[t][jj] + bp[128 - 16 * t + 3 - jj] + tp; s[t][jj] = v; mx = fmaxf(mx, v); }
    }
    mx = fmaxf(mx, __shfl_xor(mx, 16)); mx = fmaxf(mx, __shfl_xor(mx, 32));
    float l = 0.f;
#pragma unroll
    for (int t = 0; t < 9; ++t)
#pragma unroll
        for (int jj = 0; jj < 4; ++jj) { const float p = fexp(s[t][jj] - mx); s[t][jj] = p; l += p; }
    l += __shfl_xor(l, 16); l += __shfl_xor(l, 32);
    l += fexp(sinkv - mx);
    const float inv = __builtin_amdgcn_rcpf(l);
#pragma unroll
    for (int d = 0; d < NDT; ++d) o[d] = (f32x4){0.f, 0.f, 0.f, 0.f};
    const unsigned vb = vbase + (unsigned)((16 * kt0 + 4 * fq + (fr >> 2)) * 144 + 32 * dt0 + 8 * (fr & 3));
    {
        s16x4 l0[NDT], h0[NDT], l1[NDT], h1[NDT], l2[NDT], h2[NDT];
        v_read<NDT, 0, false>(vb, l0, h0); v_read<NDT, 1, false>(vb, l1, h1); v_read<NDT, 2, true>(vb, l2, h2); __builtin_amdgcn_sched_barrier(0);
        pv_mma<NDT, 0>(s, l0, h0, o); pv_mma<NDT, 1>(s, l1, h1, o); pv_mma<NDT, 2>(s, l2, h2, o);
        v_read<NDT, 3, false>(vb, l0, h0); v_read<NDT, 4, true>(vb, l1, h1); __builtin_amdgcn_sched_barrier(0);
        pv_mma<NDT, 3>(s, l0, h0, o); pv_mma<NDT, 4>(s, l1, h1, o);
    }
#pragma unroll
    for (int d = 0; d < NDT; ++d) o[d] = o[d] * inv;
}
constexpr int P2_K_OFF = 0, P2_V_OFF = 41472, P2_BIAS_OFF = 82944;
__device__ __forceinline__ void p2_bias_table(LAS unsigned char* lds, int tid) {
    const float* relb = karg<I_RELB>(); const float* sinks = karg<I_SINKS>();
    LAS float* bt = (LAS float*)(lds + P2_BIAS_OFF);
    for (int i = tid; i < 8 * 160; i += 512) { const int h = i / 160, d = i % 160 - 16; bt[i] = (d >= 0 && d <= 128) ? relb[rel_bucket(d) * 8 + h] : -1e30f; }
    if (tid < 8) bt[8 * 160 + tid] = sinks[tid];
    LDS_WAIT(); __syncthreads();
}
__device__ __forceinline__ void attn_prompt_item(const Ctx& C, LAS unsigned char* lds, unsigned ldsbase, int item, int tid, int wid, int lane) {
    const int kvh = item & 1, nb = (item >> 1) & 15, b = item >> 5, fr = lane & 15, fq = lane >> 4;
    __syncthreads();
#pragma unroll
    for (int i = 0; i < 4; ++i) { const int idx = tid + 512 * i, j = idx >> 3, ch = idx & 7, t = 128 * (nb - 1) + j;
        u32x4 kv = (u32x4){0u, 0u, 0u, 0u}, vv = (u32x4){0u, 0u, 0u, 0u};
        if (t >= 0) { const size_t off = (size_t)t * KVW + kvh * 64 + 8 * ch; kv = *(const u32x4*)(WSG(const bf16, WS_K, LR(b * SEQ)) + off); vv = *(const u32x4*)(WSG(const bf16, WS_V, LR(b * SEQ)) + off); }
        *(LAS u32x4*)(lds + P2_K_OFF + j * 144 + 16 * ch) = kv; *(LAS u32x4*)(lds + P2_V_OFF + j * 144 + 16 * ch) = vv; }
    LDS_WAIT(); __syncthreads();
    const LAS float* bt = (const LAS float*)(lds + P2_BIAS_OFF);
    const int rowb = LR(b * SEQ + nb * 128), row = row_loc(rowb) + 16 * wid + fr;
#pragma unroll 1
    for (int g = 0; g < 4; ++g) {
        const int h = 4 * kvh + g;
        const bf16* qp = WSG(const bf16, WS_QA, rowb) + (size_t)row * QW + h * 64 + 8 * fq;
        const bf16x8 q0 = *(const bf16x8*)qp, q1 = *(const bf16x8*)(qp + 32);
        f32x4 o[4];
        attn_core<4>(q0, q1, lds + P2_K_OFF, ldsbase + P2_V_OFF, wid, 128 + 16 * wid + fr, nb == 0 ? 8 : 0, bt[8 * 160 + h], bt + h * 160, 0, fr, fq, o);
        bf16* op = WSG(bf16, WS_QA, rowb) + (size_t)row * QW + h * 64 + 4 * fq;
#pragma unroll
        for (int d = 0; d < 4; ++d) { u32x2 w; w.x = pk2(o[d][0], o[d][1]); w.y = pk2(o[d][2], o[d][3]); *(u32x2*)(op + 16 * d) = w; }
    }
}
__device__ __forceinline__ void attn_sample_item(const Ctx& C, LAS unsigned char* lds, unsigned ldsbase, int b, int tid, int wid, int lane) {
    const int fr = lane & 15, fq = lane >> 4;
    const float* ck = karg<I_CK>(); const float* cv = karg<I_CV>();
    __syncthreads();
    for (int idx = tid; idx < 144 * 32; idx += 512) { const int j = idx >> 5, c4 = idx & 31, kvh = c4 >> 4, d0 = (c4 & 15) * 4;
        f32x4 kf = (f32x4){0.f, 0.f, 0.f, 0.f}, vf = (f32x4){0.f, 0.f, 0.f, 0.f};
        if (j < 128) { const size_t off = ((size_t)(b * 128 + j) * 2 + kvh) * 64 + d0; kf = NT_LD((const f32x4*)(ck + off)); vf = NT_LD((const f32x4*)(cv + off)); }
        else if (j < 132) { const int lr_ = LR(MP + 4 * b); const size_t off = (size_t)(row_loc(lr_) + j - 128) * KVW + kvh * 64 + d0; const u32x2 kw = *(const u32x2*)(WSG(const bf16, WS_K, lr_) + off), vw = *(const u32x2*)(WSG(const bf16, WS_V, lr_) + off);
            kf = (f32x4){bflo(kw.x), bfhi(kw.x), bflo(kw.y), bfhi(kw.y)}; vf = (f32x4){bflo(vw.x), bfhi(vw.x), bflo(vw.y), bfhi(vw.y)}; }
        u32x2 kw, vw; kw.x = pk2(kf[0], kf[1]); kw.y = pk2(kf[2], kf[3]); vw.x = pk2(vf[0], vf[1]); vw.y = pk2(vf[2], vf[3]);
        *(LAS u32x2*)(lds + P2_K_OFF + (kvh * 144 + j) * 144 + 2 * d0) = kw; *(LAS u32x2*)(lds + P2_V_OFF + (kvh * 144 + j) * 144 + 2 * d0) = vw; }
    const int kvh = wid >> 2, dt = wid & 3, i = fr >> 2, g = fr & 3, h = 4 * kvh + g, rowb = LR(MP + 4 * b), row = row_loc(rowb) + i;
    const bf16* qp = WSG(const bf16, WS_QA, rowb) + (size_t)row * QW + h * 64 + 8 * fq;
    const bf16x8 q0 = *(const bf16x8*)qp, q1 = *(const bf16x8*)(qp + 32);
    VM_WAIT(); LDS_WAIT(); __syncthreads();
    const LAS float* bt = (const LAS float*)(lds + P2_BIAS_OFF);
    f32x4 o[1];
    attn_core<1>(q0, q1, lds + P2_K_OFF + kvh * 144 * 144, ldsbase + P2_V_OFF + kvh * 144 * 144, 0, 128 + i, 0, bt[8 * 160 + h], bt + h * 160, dt, fr, fq, o);
    u32x2 w; w.x = pk2(o[0][0], o[0][1]); w.y = pk2(o[0][2], o[0][3]);
    *(u32x2*)(WSG(bf16, WS_QA, rowb) + (size_t)row * QW + h * 64 + 16 * dt + 4 * fq) = w;
}

constexpr int RG_XC_OFF = 0, RG_HS_OFF = 36864, RG_TOT_OFF = 36864 + 69632;
__device__ __forceinline__ void rg_gate(float rp, float ip, float xv, float ba, float bx, float csp, float& a, float& bt) {
    const float r = fsigmoid(rp + ba), i = fsigmoid(ip + bx), la = csp * r;
    a = fexp(la);
    const float x2 = la + la;
    const float tay = -x2 * (1.f + x2 * 0.5f * (1.f + x2 * (1.f / 3.f) * (1.f + x2 * 0.25f * (1.f + x2 * 0.2f * (1.f + x2 * (1.f / 6.f))))));
    const float om = x2 > -0.25f ? tay : 1.f - a * a;
    bt = __builtin_amdgcn_sqrtf(om) * (i * xv);
}
struct RgW { bf16x8 wa[2], wx[2], idf[2]; float ba, bx, csp; };
__device__ __forceinline__ void rg_load_w(const Ctx& C, RgW& w, int cb, int eg, int fr, int fq) {
    const bf16* pa = WSP(const bf16, WS_WRGA) + (size_t)(cb * 64 + 16 * eg + fr) * 64 + 8 * fq;
    const bf16* px = WSP(const bf16, WS_WRGX) + (size_t)(cb * 64 + 16 * eg + fr) * 64 + 8 * fq;
#pragma unroll
    for (int ks = 0; ks < 2; ++ks) { w.wa[ks] = *(const bf16x8*)(pa + 32 * ks); w.wx[ks] = *(const bf16x8*)(px + 32 * ks);
        bf16x8 id;
#pragma unroll
        for (int jj = 0; jj < 8; ++jj) id[jj] = (32 * ks + 8 * fq + jj == 16 * eg + fr) ? (short)0x3F80 : (short)0;
        w.idf[ks] = id; }
    const int ch = 64 * cb + 16 * eg + fr;
    w.ba = karg<I_RGBA>()[ch]; w.bx = karg<I_RGBX>()[ch];
    w.csp = -8.0f * log1pf(__expf(-karg<I_RGLAM>()[ch]));
}
__device__ __forceinline__ void rglru_prompt_loop(const Ctx& C, LAS unsigned char* lds, int tid, int wid, int lane) {
    int item = (C.G == 128) ? 64 * (C.c >> 6) + 16 * (C.c & 3) + ((C.c >> 2) & 15) : C.c; if (item >= 512) return;
    const int fr = lane & 15, fq = lane >> 4, eg = wid & 3, th = wid >> 2, o8 = tid & 7, tq = tid >> 3;
    LAS unsigned char* XC = lds + RG_XC_OFF; LAS float* HS = (LAS float*)(lds + RG_HS_OFF); LAS float* TOT = (LAS float*)(lds + RG_TOT_OFF);
    unsigned long long* agg = WSP(unsigned long long, WS_AGG);
    unsigned* flags = WSP(unsigned, WS_FLAGS);
    RgW W; f32x4 cw[4][2], cbv[2]; int cur_bcb = -1;
    u32x4 xr[7], gr[4];
#define RG_LOAD_XR(it) do { const int _c = (it) >> 6, _b = 4 * C.dom + (((it) >> 4) & 3), _cb = (it) & 15; \
        _Pragma("unroll") for (int j = 0; j < 7; ++j) { const int tt = _c * 256 + 4 * tq - 3 + j; \
            xr[j] = *(const u32x4*)(WSG(const bf16, WS_XR, LR(_b * SEQ)) + (size_t)(tt < 0 ? 0 : tt) * D + 64 * _cb + 8 * o8); } } while (0)
#define RG_LOAD_GR(it) do { const int _c = (it) >> 6, _b = 4 * C.dom + (((it) >> 4) & 3), _cb = (it) & 15; \
        _Pragma("unroll") for (int q = 0; q < 4; ++q) gr[q] = *(const u32x4*)(WSG(const bf16, WS_GR, LR(_b * SEQ)) + (size_t)(_c * 256 + 4 * tq + q) * D + 64 * _cb + 8 * o8); } while (0)
    RG_LOAD_XR(item); RG_LOAD_GR(item);
#pragma unroll 1
    for (;;) {
        const int cidx = item >> 6, b = 4 * C.dom + ((item >> 4) & 3), cb = item & 15, bcb = b * 16 + cb, ch = 64 * cb + 16 * eg + fr, t0 = cidx * 256;
        const int nitem = item + C.G;
        if (bcb != cur_bcb) {
            cur_bcb = bcb; rg_load_w(C, W, cb, eg, fr, fq);
            const float* convw = karg<I_CONVW>() + 64 * cb + 8 * o8; const float* convb = karg<I_CONVB>() + 64 * cb + 8 * o8;
            cbv[0] = *(const f32x4*)convb; cbv[1] = *(const f32x4*)(convb + 4);
#pragma unroll
            for (int j = 0; j < 4; ++j) { cw[j][0] = *(const f32x4*)(convw + j * D); cw[j][1] = *(const f32x4*)(convw + j * D + 4); }
        }
        __syncthreads();
        {
            f32x4 xf[7][2];
#pragma unroll
            for (int j = 0; j < 7; ++j) { const float z = (t0 + 4 * tq - 3 + j >= 0) ? 1.f : 0.f; const u32x4 xv = xr[j];
                xf[j][0] = (f32x4){bflo(xv.x), bfhi(xv.x), bflo(xv.y), bfhi(xv.y)} * z; xf[j][1] = (f32x4){bflo(xv.z), bfhi(xv.z), bflo(xv.w), bfhi(xv.w)} * z; }
#pragma unroll
            for (int q = 0; q < 4; ++q) {
                f32x4 x0 = cbv[0], x1 = cbv[1];
#pragma unroll
                for (int j = 0; j < 4; ++j) { x0 += cw[j][0] * xf[q + j][0]; x1 += cw[j][1] * xf[q + j][1]; }
                u32x4 w; w.x = pk2(x0[0], x0[1]); w.y = pk2(x0[2], x0[3]); w.z = pk2(x1[0], x1[1]); w.w = pk2(x1[2], x1[3]);
                *(LAS u32x4*)(XC + (4 * tq + q) * 144 + 16 * o8) = w;
            }
        }
        LDS_WAIT(); __syncthreads();
        if (nitem < 512) RG_LOAD_XR(nitem);
        float av[2][4][4], bv[2][4][4], Ae[2], Be[2], Ag[2], Bg[2];
#pragma unroll
        for (int g2 = 0; g2 < 2; ++g2) {
            float Ai = 1.f, Bi = 0.f;
            const LAS unsigned char* ap = XC + (128 * th + 64 * g2 + 16 * (fr >> 2) + (fr & 3)) * 144 + 16 * fq;
#pragma unroll
            for (int m = 0; m < 4; ++m) {
                const bf16x8 a0 = *(const LAS bf16x8*)(ap + m * 576), a1 = *(const LAS bf16x8*)(ap + m * 576 + 64);
                f32x4 rp = (f32x4){0.f, 0.f, 0.f, 0.f}, ip = rp, xv = rp;
                rp = MFMA16(a0, W.wa[0], rp); rp = MFMA16(a1, W.wa[1], rp);
                ip = MFMA16(a0, W.wx[0], ip); ip = MFMA16(a1, W.wx[1], ip);
                xv = MFMA16(a0, W.idf[0], xv); xv = MFMA16(a1, W.idf[1], xv);
#pragma unroll
                for (int jj = 0; jj < 4; ++jj) { rg_gate(rp[jj], ip[jj], xv[jj], W.ba, W.bx, W.csp, av[g2][m][jj], bv[g2][m][jj]); Bi = av[g2][m][jj] * Bi + bv[g2][m][jj]; Ai *= av[g2][m][jj]; }
            }
            { const float Ap = __shfl_up(Ai, 16), Bp = __shfl_up(Bi, 16); if (fq >= 1) { Bi = Ai * Bp + Bi; Ai = Ai * Ap; } }
            { const float Ap = __shfl_up(Ai, 32), Bp = __shfl_up(Bi, 32); if (fq >= 2) { Bi = Ai * Bp + Bi; Ai = Ai * Ap; } }
            { const float Ap = __shfl_up(Ai, 16), Bp = __shfl_up(Bi, 16); Ae[g2] = fq ? Ap : 1.f; Be[g2] = fq ? Bp : 0.f; }
            Ag[g2] = __shfl(Ai, 48 + fr); Bg[g2] = __shfl(Bi, 48 + fr);
        }
        const float Aw = Ag[1] * Ag[0], Bw = Ag[1] * Bg[0] + Bg[1];
        if (fq == 0) { TOT[(th * 64 + 16 * eg + fr) * 2] = Aw; TOT[(th * 64 + 16 * eg + fr) * 2 + 1] = Bw; }
        LDS_WAIT(); __syncthreads();
        const float A0 = TOT[(16 * eg + fr) * 2], B0 = TOT[(16 * eg + fr) * 2 + 1], A1 = TOT[(64 + 16 * eg + fr) * 2], B1 = TOT[(64 + 16 * eg + fr) * 2 + 1];
        if (th == 1 && fq == 0) { const float Ac = A1 * A0, Hc = A1 * B0 + B1;
            __hip_atomic_store(agg + (size_t)(cidx * 128 + bcb) * 64 + 16 * eg + fr, ((unsigned long long)__float_as_uint(Hc) << 32) | __float_as_uint(Ac), __ATOMIC_RELAXED, __HIP_MEMORY_SCOPE_AGENT); }
        VM_WAIT(); __syncthreads();
        if (tid == 0) __hip_atomic_store(flags + cidx * 128 + bcb, 1u, __ATOMIC_RELAXED, __HIP_MEMORY_SCOPE_AGENT);
        float hc = 0.f;
        if (cidx > 0) {
            unsigned sp = 0;
            for (;;) { const unsigned f = (lane < cidx) ? __hip_atomic_load(flags + lane * 128 + bcb, __ATOMIC_RELAXED, __HIP_MEMORY_SCOPE_AGENT) : 1u;
                if (__all(f != 0u)) break;
                __builtin_amdgcn_s_sleep(1); if (++sp > (1u << 20)) break; }
            unsigned long long w[7];
#pragma unroll
            for (int j = 0; j < 7; ++j) w[j] = (j < cidx) ? __hip_atomic_load(agg + (size_t)(j * 128 + bcb) * 64 + 16 * eg + fr, __ATOMIC_RELAXED, __HIP_MEMORY_SCOPE_AGENT) : 0ull;
#pragma unroll
            for (int j = 0; j < 7; ++j) if (j < cidx) hc = __uint_as_float((unsigned)w[j]) * hc + __uint_as_float((unsigned)(w[j] >> 32));
        }
        const float hmid = A0 * hc + B0;
        float hin = th ? hmid : hc;
#pragma unroll
        for (int g2 = 0; g2 < 2; ++g2) {
            float hl = Ae[g2] * hin + Be[g2];
#pragma unroll
            for (int m = 0; m < 4; ++m)
#pragma unroll
                for (int jj = 0; jj < 4; ++jj) { hl = av[g2][m][jj] * hl + bv[g2][m][jj]; HS[(128 * th + 64 * g2 + 16 * fq + 4 * m + jj) * 68 + 16 * eg + fr] = hl; }
            hin = Ag[g2] * hin + Bg[g2];
        }
        if (cidx == 7 && th == 0 && fq == 0) C.out[O_HP + (size_t)b * D + ch] = A1 * hmid + B1;
        LDS_WAIT(); __syncthreads();
#pragma unroll
        for (int q = 0; q < 4; ++q) {
            const int tl = 4 * tq + q;
            const f32x4 h0 = *(const LAS f32x4*)(HS + tl * 68 + 8 * o8), h1 = *(const LAS f32x4*)(HS + tl * 68 + 8 * o8 + 4);
            const u32x4 g = gr[q];
            st_bf16x8(WSG(bf16, WS_GR, LR(b * SEQ)) + (size_t)(t0 + tl) * D + 64 * cb + 8 * o8, h0 * (f32x4){bflo(g.x), bfhi(g.x), bflo(g.y), bfhi(g.y)}, h1 * (f32x4){bflo(g.z), bfhi(g.z), bflo(g.w), bfhi(g.w)});
        }
        if (nitem >= 512) break;
        RG_LOAD_GR(nitem);
        item = nitem;
    }
#undef RG_LOAD_XR
#undef RG_LOAD_GR
}
__device__ __forceinline__ void rglru_sample_item(const Ctx& C, LAS unsigned char* lds, int cb, int bg, int tid, int wid, int lane) {
    const int fr = lane & 15, fq = lane >> 4, eg = wid & 3, th = wid >> 2, ch = 64 * cb + 16 * eg + fr;
    LAS unsigned char* XC = lds + RG_XC_OFF; LAS float* HS = (LAS float*)(lds + RG_HS_OFF);
    RgW W; rg_load_w(C, W, cb, eg, fr, fq);
    const int o8 = tid & 7, tl = tid >> 3, bb = 16 * bg + (tl >> 2), ii = tl & 3;
    __syncthreads();
    {
        const float* convw = karg<I_CONVW>(); const float* convb = karg<I_CONVB>(); const float* sconv = karg<I_SCONV>();
        float xc[8];
#pragma unroll
        for (int e = 0; e < 8; ++e) xc[e] = convb[64 * cb + 8 * o8 + e];
#pragma unroll
        for (int j = 0; j < 4; ++j) { const int tt = ii - 3 + j; float xin[8];
            if (tt >= 0) { const u32x4 xv = *(const u32x4*)(WSG(const bf16, WS_XR, LR(MP + 64 * bg)) + (size_t)(2048 + 4 * (tl >> 2) + tt) * D + 64 * cb + 8 * o8);
                xin[0] = bflo(xv.x); xin[1] = bfhi(xv.x); xin[2] = bflo(xv.y); xin[3] = bfhi(xv.y); xin[4] = bflo(xv.z); xin[5] = bfhi(xv.z); xin[6] = bflo(xv.w); xin[7] = bfhi(xv.w); }
            else { const float* sp = sconv + (size_t)(bb * 3 + ii + j) * D + 64 * cb + 8 * o8; const f32x4 s0 = *(const f32x4*)sp, s1 = *(const f32x4*)(sp + 4);
                xin[0] = s0[0]; xin[1] = s0[1]; xin[2] = s0[2]; xin[3] = s0[3]; xin[4] = s1[0]; xin[5] = s1[1]; xin[6] = s1[2]; xin[7] = s1[3]; }
            const f32x4 w0 = *(const f32x4*)(convw + j * D + 64 * cb + 8 * o8), w1 = *(const f32x4*)(convw + j * D + 64 * cb + 8 * o8 + 4);
#pragma unroll
            for (int e = 0; e < 4; ++e) { xc[e] += w0[e] * xin[e]; xc[4 + e] += w1[e] * xin[4 + e]; } }
        u32x4 w; w.x = pk2(xc[0], xc[1]); w.y = pk2(xc[2], xc[3]); w.z = pk2(xc[4], xc[5]); w.w = pk2(xc[6], xc[7]);
        *(LAS u32x4*)(XC + tl * 144 + 16 * o8) = w;
    }
    LDS_WAIT(); __syncthreads();
    {
        const float* sh = karg<I_SH>();
#pragma unroll
        for (int mm = 0; mm < 2; ++mm) {
            const int m = 2 * th + mm, bq = 16 * bg + 4 * m + fq;
            const LAS unsigned char* ap = XC + (16 * m + fr) * 144 + 16 * fq;
            const bf16x8 a0 = *(const LAS bf16x8*)ap, a1 = *(const LAS bf16x8*)(ap + 64);
            f32x4 rp = (f32x4){0.f, 0.f, 0.f, 0.f}, ip = rp, xv = rp;
            rp = MFMA16(a0, W.wa[0], rp); rp = MFMA16(a1, W.wa[1], rp);
            ip = MFMA16(a0, W.wx[0], ip); ip = MFMA16(a1, W.wx[1], ip);
            xv = MFMA16(a0, W.idf[0], xv); xv = MFMA16(a1, W.idf[1], xv);
            float h = sh[(size_t)bq * D + ch];
#pragma unroll
            for (int jj = 0; jj < 4; ++jj) { float a, bt; rg_gate(rp[jj], ip[jj], xv[jj], W.ba, W.bx, W.csp, a, bt); h = a * h + bt; HS[(16 * m + 4 * fq + jj) * 68 + 16 * eg + fr] = h; }
            C.out[O_HS + (size_t)bq * D + ch] = h;
        }
    }
    LDS_WAIT(); __syncthreads();
    {
        const f32x4 h0 = *(const LAS f32x4*)(HS + tl * 68 + 8 * o8), h1 = *(const LAS f32x4*)(HS + tl * 68 + 8 * o8 + 4);
        bf16* gp = WSG(bf16, WS_GR, LR(MP + 64 * bg)) + (size_t)(2048 + tl) * D + 64 * cb + 8 * o8;
        f32x4 g0, g1; ld_bf16x8(gp, g0, g1);
        st_bf16x8(gp, h0 * g0, h1 * g1);
    }
}
__device__ __forceinline__ void p2_phase(const Ctx& C, LAS unsigned char* lds, unsigned ldsbase, unsigned* scnt, int tid, int wid, int lane) {
    rglru_prompt_loop(C, lds, tid, wid, lane);
    __syncthreads();
    p2_bias_table(lds, tid);
#pragma unroll 1
    for (int it = C.c; it < 128; it += C.G) { const int itg = (C.G == 128) ? 32 * (it & 3) + (it >> 2) : it;
        attn_prompt_item(C, lds, ldsbase, (4 * C.dom + (itg >> 5)) * 32 + (itg & 31), tid, wid, lane); }
    if (tid == 0) { unsigned sp = 0; while (__hip_atomic_load(scnt, __ATOMIC_RELAXED, __HIP_MEMORY_SCOPE_AGENT) < 19u) { __builtin_amdgcn_s_sleep(2); if (++sp > (1u << 22)) break; }
        __builtin_amdgcn_fence(__ATOMIC_ACQUIRE, "agent"); VM_WAIT(); }
    __syncthreads();
    for (int vb0 = C.c; vb0 < 128; vb0 += C.G) {
        const int vb = (C.G == 128) ? (((vb0 >> 2) < 16) ? 16 * (vb0 & 3) + (vb0 >> 2) : 64 + 16 * (vb0 & 3) + ((vb0 >> 2) - 16)) : vb0;
        if (vb >= 64) attn_sample_item(C, lds, ldsbase, 64 * C.dom + vb - 64, tid, wid, lane);
        else { __syncthreads(); rglru_sample_item(C, lds, vb & 15, 4 * C.dom + (vb >> 4), tid, wid, lane); }
    }
    __syncthreads();
}

__global__ void __launch_bounds__(512, 2) mk_fwd(Args args) {
    extern __shared__ __attribute__((aligned(16))) unsigned char lds_raw[];
    LAS unsigned char* lds = (LAS unsigned char*)lds_raw;
    const unsigned ldsbase = (unsigned)(size_t)lds_raw;
    const int wid = __builtin_amdgcn_readfirstlane((int)threadIdx.x >> 6);
#define FRESH_IDS const int lane = lane_fresh(), tid = wid * 64 + lane
    Ctx C;
    C.out = args.out; C.ws = args.ws; C.p0 = nullptr; C.p1 = nullptr;
    const int NG = gridDim.x;
    C.G = NG >> 1; C.c = blockIdx.x >> 1; C.dom = blockIdx.x & 1;
    C.wd = args.ws + WS_ACT + (size_t)C.dom * DOM_STRIDE;
    const int vcu = (NG % 8 == 0) ? (int)(blockIdx.x % 8) * (NG / 8) + (int)blockIdx.x / 8 : (int)blockIdx.x;
    { FRESH_IDS; for (int u = tid; u < (LDS_BYTES - 131072) / 4; u += 512) ((LAS unsigned*)(lds + 131072))[u] = 0u; }
    __syncthreads();
    const int lo = args.ph_lo, hi = args.ph_hi;
    unsigned* bar_all = (unsigned*)(args.ws + WS_CTL);
    unsigned* bar = bar_all + XCD_BAR_WORDS * (1 + C.dom);
    unsigned* ev = bar_all + 64;
    volatile LAS unsigned* bst_all = (volatile LAS unsigned*)(lds + MISC_OFF) + 8;
    volatile LAS unsigned* bst = (volatile LAS unsigned*)(lds + MISC_OFF) + 12;
    const bool grp = (C.G == 128);
    unsigned* gbar = (unsigned*)(args.ws + WS_GBAR) + XCD_BAR_WORDS * (4 * C.dom + (C.c & 3));
    volatile LAS unsigned* bst_g = (volatile LAS unsigned*)(lds + MISC_OFF) + 16;
    if (hi - lo > 1) { xcd_barrier_post(bar_all, wid); xcd_barrier_post(bar, wid); if (grp) xcd_barrier_post(gbar, wid); }
#define IN(k) (lo <= (k) && (k) < hi)
#define SEAM(k) do { if (IN(k) && IN((k) + 1)) xcd_barrier(bar, bst, (unsigned)C.G, wid); } while (0)
#define GSEAM(k) do { if (IN(k) && IN((k) + 1)) { if (grp) xcd_barrier(gbar, bst_g, 32u, wid, true); else xcd_barrier(bar, bst, (unsigned)C.G, wid); } } while (0)
    if (IN(0)) {
        { FRESH_IDS; p0a_prologue(C, lds, vcu, NG, tid, wid, lane); }
        if (IN(1)) xcd_barrier(bar_all, bst_all, (unsigned)NG, wid, false, true);
        if (grp) {
            const int q = 4 * C.dom + (C.c & 3);
            const int st = q <= 1 ? 0 : q == 2 ? 123 : q == 3 ? 390 : q == 4 ? 830 : q == 5 ? 1484 : q == 6 ? 2424 : 3794;
            const int en = q == 0 ? 0 : q == 1 ? 123 : q == 2 ? 390 : q == 3 ? 830 : q == 4 ? 1484 : q == 5 ? 2424 : q == 6 ? 3794 : (1 << 30);
            if (q > 0) {
                { FRESH_IDS; p0b_prologue(C, lds, C.c >> 2, 32, st, en, tid, wid, lane); }
                VM_WAIT(); __syncthreads();
                if (wid == 0 && lane_fresh() == 0) __hip_atomic_fetch_add(ev, 1u, __ATOMIC_RELAXED, __HIP_MEMORY_SCOPE_AGENT);
            }
        } else if (C.dom == 1) {
            { FRESH_IDS; p0b_prologue(C, lds, C.c, C.G, 0, 1 << 30, tid, wid, lane); }
            VM_WAIT(); __syncthreads();
            if (wid == 0 && lane_fresh() == 0) __hip_atomic_fetch_add(ev, 1u, __ATOMIC_RELAXED, __HIP_MEMORY_SCOPE_AGENT);
        }
    }
    unsigned* scnt = bar_all + 80 + C.dom;
    if (IN(1)) { C.p0 = karg<I_QG>(); C.p1 = karg<I_KG>();
        const int ns = gemm_phase<PH_IN>(lds, C, wid);
        if (ns > 0 && wid == 0 && lane_fresh() == 0) __hip_atomic_fetch_add(scnt, (unsigned)ns, __ATOMIC_RELAXED, __HIP_MEMORY_SCOPE_AGENT);
        GSEAM(1); }
    if (IN(2)) { { FRESH_IDS; p2_phase(C, lds, ldsbase, scnt, tid, wid, lane); }
        if (IN(3) && IN(0) && wid == 0 && lane_fresh() == 0) { unsigned sp = 0; while (__hip_atomic_load(ev, __ATOMIC_RELAXED, __HIP_MEMORY_SCOPE_AGENT) < (grp ? 224u : (unsigned)C.G)) { __builtin_amdgcn_s_sleep(2); if (++sp > (1u << 22)) break; } }
        GSEAM(2); }
    if (IN(3)) { gemm_phase<PH_MIX>(lds, C, wid); GSEAM(3); }
    if (IN(4)) { C.p0 = karg<I_XP>(); C.p1 = karg<I_XS>();
        gemm_phase<PH_OUT>(lds, C, wid); GSEAM(4); }
    if (IN(5)) {
        gemm_phase<PH_UP>(lds, C, wid);
        GSEAM(5); }
    if (IN(6)) { gemm_phase<PH_DOWN>(lds, C, wid); GSEAM(6); }
    if (IN(7)) { gemm_phase<PH_PLE>(lds, C, wid); if (C.dom == 0) { FRESH_IDS; cache_shift(C, C.c, C.G, tid); } }
#undef FRESH_IDS
#undef IN
#undef SEAM
#undef GSEAM
}

extern "C" void kernel_launch(void* const* d_in, const int* in_sizes, int n_in, void* d_out, int out_size, void* d_ws, size_t ws_size, hipStream_t stream) {
    static int grid = 0;
    if (grid == 0) {
        if (n_in != 30 || ws_size < WS_END) { fprintf(stderr, "kernel_launch: built for 30 inputs and >= %zu bytes of workspace; got n_in %d, ws %zu\n", (size_t)WS_END, n_in, ws_size); grid = -1; return; }
        int dev = 0, cus = 0, per_cu = 0;
        if (hipGetDevice(&dev) != hipSuccess || hipDeviceGetAttribute(&cus, hipDeviceAttributeMultiprocessorCount, dev) != hipSuccess) { grid = -1; return; }
        if (hipFuncSetAttribute((const void*)mk_fwd, hipFuncAttributeMaxDynamicSharedMemorySize, LDS_BYTES) != hipSuccess) { fprintf(stderr, "kernel_launch: hipFuncSetAttribute failed\n"); grid = -1; return; }
        if (hipOccupancyMaxActiveBlocksPerMultiprocessor(&per_cu, (const void*)mk_fwd, 512, LDS_BYTES) != hipSuccess || per_cu < 1) fprintf(stderr, "kernel_launch: occupancy query reports %d\n", per_cu);
        (void)hipGetLastError();
        grid = cus & ~1;
    }
    if (grid < 0) return;
    (void)hipMemsetAsync((char*)d_ws + WS_CTL, 0, CTL_ZERO_BYTES, stream);
    Args a{};
    for (int i = 0; i < 30; ++i) a.in[i] = (const float*)d_in[i];
    a.out = (float*)d_out; a.ws = (unsigned char*)d_ws;
#if MK_LAUNCHES == 1
    a.ph_lo = 0; a.ph_hi = 8;
    hipLaunchKernelGGL(mk_fwd, dim3(grid), dim3(512), LDS_BYTES, stream, a);
#else
    for (int ph = 0; ph < 8; ++ph) { a.ph_lo = ph; a.ph_hi = ph + 1; hipLaunchKernelGGL(mk_fwd, dim3(grid), dim3(512), LDS_BYTES, stream, a); }
#endif
}
```
